# Optimizing an MI355X kernel written in HIP

```python
import jax, jax.numpy as jnp
from jax import lax
import numpy as np

D_MODEL = 2048
BATCH = 4
SEQ = 2048
DEPTH = 2

HEAD_DIM = 64
N_Q_HEADS = 16
N_KV_HEADS = 4
Q_PER_KV = N_Q_HEADS // N_KV_HEADS
ATTN_WIDTH = N_Q_HEADS * HEAD_DIM
KV_WIDTH = N_KV_HEADS * HEAD_DIM
WINDOW = 128
BLOCK = 128
ROPE_THETA = 10000.0
SGU_GROUPS = 8
SGU_GROUP_DIM = 128
SGU_WIDTH = SGU_GROUPS * SGU_GROUP_DIM
CHUNK = 128
N_BRANCHES = 2
D_FF = ((-(-8 * D_MODEL // 3) + 255) // 256) * 256
IN_WIDTH = ATTN_WIDTH + 2 * KV_WIDTH + 2 * SGU_WIDTH + N_BRANCHES * D_MODEL
EPS = 1e-6

kernel_name = "hybrid_gated_swa_sgu_block"


def rms_norm(x, g):
    xf = x.astype(jnp.float32)
    y = xf * lax.rsqrt(jnp.mean(xf * xf, axis=-1, keepdims=True) + EPS)
    return (y * g.astype(jnp.float32)).astype(x.dtype)


def rope_tables(seq):
    pos = jnp.arange(seq, dtype=jnp.float32)
    inv_freq = jnp.power(ROPE_THETA, -jnp.arange(0, HEAD_DIM, 2, dtype=jnp.float32) / HEAD_DIM)
    ang = pos[:, None] * inv_freq[None, :]
    return jnp.cos(ang), jnp.sin(ang)


def apply_rope(x, cos, sin):
    xf = x.astype(jnp.float32)
    half = HEAD_DIM // 2
    x1, x2 = xf[..., :half], xf[..., half:]
    c, s = cos[None, :, None, :], sin[None, :, None, :]
    return jnp.concatenate([x1 * c - x2 * s, x2 * c + x1 * s], axis=-1).astype(x.dtype)


def sliding_window_attention(q, k, v, sinks):
    B, S = q.shape[0], q.shape[1]
    nb = S // BLOCK
    qb = q.reshape(B, nb, BLOCK, N_KV_HEADS, Q_PER_KV, HEAD_DIM)
    kb = k.reshape(B, nb, BLOCK, N_KV_HEADS, HEAD_DIM)
    vb = v.reshape(B, nb, BLOCK, N_KV_HEADS, HEAD_DIM)

    def with_prev(t):
        prev = jnp.pad(t[:, :-1], ((0, 0), (1, 0), (0, 0), (0, 0), (0, 0)))
        return jnp.concatenate([prev, t], axis=2)

    kw, vw = with_prev(kb), with_prev(vb)
    scale = HEAD_DIM ** -0.5
    scores = jnp.einsum('bnqhgd,bnkhd->bnhgqk', qb, kw).astype(jnp.float32) * scale
    q_pos = jnp.arange(BLOCK)[:, None] + BLOCK
    k_pos = jnp.arange(2 * BLOCK)[None, :]
    diff = q_pos - k_pos
    band = (diff >= 0) & (diff < WINDOW)
    valid = (jnp.arange(nb)[:, None, None] > 0) | (k_pos >= BLOCK)[None]
    mask = (band[None] & valid)[None, :, None, None]
    scores = jnp.where(mask, scores, -1e30)
    sink = jnp.broadcast_to(
        sinks.astype(jnp.float32).reshape(N_KV_HEADS, Q_PER_KV)[None, None, :, :, None, None],
        scores.shape[:-1] + (1,))
    probs = jax.nn.softmax(jnp.concatenate([scores, sink], axis=-1), axis=-1)[..., :-1]
    out = jnp.einsum('bnhgqk,bnkhd->bnqhgd', probs.astype(v.dtype), vw)
    return out.reshape(B, S, ATTN_WIDTH)


def chunked_sgu(uv, w_s, b_s, ln_g, ln_b):
    B, S = uv.shape[0], uv.shape[1]
    nc = S // CHUNK
    u, v = uv[..., :SGU_WIDTH], uv[..., SGU_WIDTH:]
    vf = v.astype(jnp.float32).reshape(B, S, SGU_GROUPS, SGU_GROUP_DIM)
    mu = jnp.mean(vf, axis=-1, keepdims=True)
    var = jnp.mean(jnp.square(vf - mu), axis=-1, keepdims=True)
    vn = ((vf - mu) * lax.rsqrt(var + EPS) * ln_g.reshape(SGU_GROUPS, SGU_GROUP_DIM)
          + ln_b.reshape(SGU_GROUPS, SGU_GROUP_DIM)).astype(v.dtype)
    vc = vn.reshape(B, nc, CHUNK, SGU_GROUPS, SGU_GROUP_DIM)
    tri = jnp.tril(jnp.ones((CHUNK, CHUNK), dtype=bool))
    w = jnp.where(tri[None], w_s, jnp.zeros_like(w_s))
    s = jnp.einsum('gij,bnjgd->bnigd', w, vc) + jnp.transpose(b_s)[None, None, :, :, None]
    return u * s.reshape(B, S, SGU_WIDTH)


def setup_inputs(seed: int = 0) -> dict:
    key = jax.random.key(seed)
    ks = jax.random.split(key, 17)
    D = D_MODEL

    def nrm(k, shape, scale):
        return jax.random.normal(k, shape, jnp.float32) * scale

    return {
        "x": nrm(ks[0], (BATCH, SEQ, D), 1.0),
        "mix_norm": 1.0 + nrm(ks[1], (DEPTH, D), 0.02),
        "w_in": nrm(ks[2], (DEPTH, D, IN_WIDTH), D ** -0.5),
        "q_norm": 1.0 + nrm(ks[3], (DEPTH, HEAD_DIM), 0.02),
        "k_norm": 1.0 + nrm(ks[4], (DEPTH, HEAD_DIM), 0.02),
        "sinks": nrm(ks[5], (DEPTH, N_Q_HEADS), 0.5),
        "sgu_ln_g": 1.0 + nrm(ks[6], (DEPTH, SGU_WIDTH), 0.02),
        "sgu_ln_b": nrm(ks[7], (DEPTH, SGU_WIDTH), 0.02),
        "w_spatial": nrm(ks[8], (DEPTH, SGU_GROUPS, CHUNK, CHUNK), 0.5 * CHUNK ** -0.5),
        "b_spatial": 1.0 + nrm(ks[9], (DEPTH, SGU_GROUPS, CHUNK), 0.02),
        "w_attn_branch": nrm(ks[10], (DEPTH, ATTN_WIDTH, D), ATTN_WIDTH ** -0.5),
        "w_sgu_branch": nrm(ks[11], (DEPTH, SGU_WIDTH, D), SGU_WIDTH ** -0.5),
        "w_out": nrm(ks[12], (DEPTH, D, D), D ** -0.5),
        "ffn_norm": 1.0 + nrm(ks[13], (DEPTH, D), 0.02),
        "w_gate": nrm(ks[14], (DEPTH, D, D_FF), D ** -0.5),
        "w_up": nrm(ks[15], (DEPTH, D, D_FF), D ** -0.5),
        "w_down": nrm(ks[16], (DEPTH, D_FF, D), D_FF ** -0.5),
    }


def reference(x, mix_norm, w_in, q_norm, k_norm, sinks, sgu_ln_g, sgu_ln_b, w_spatial,
              b_spatial, w_attn_branch, w_sgu_branch, w_out, ffn_norm, w_gate, w_up, w_down):
    B, S = x.shape[0], x.shape[1]
    cos, sin = rope_tables(S)
    cuts = [ATTN_WIDTH, ATTN_WIDTH + KV_WIDTH, ATTN_WIDTH + 2 * KV_WIDTH,
            ATTN_WIDTH + 2 * KV_WIDTH + 2 * SGU_WIDTH]
    for l in range(DEPTH):
        h = rms_norm(x, mix_norm[l])
        proj = h @ w_in[l]
        q, k, v, uv, gate_logits = jnp.split(proj, cuts, axis=-1)
        q = apply_rope(rms_norm(q.reshape(B, S, N_Q_HEADS, HEAD_DIM), q_norm[l]), cos, sin)
        k = apply_rope(rms_norm(k.reshape(B, S, N_KV_HEADS, HEAD_DIM), k_norm[l]), cos, sin)
        v = v.reshape(B, S, N_KV_HEADS, HEAD_DIM)
        branch_a = sliding_window_attention(q, k, v, sinks[l]) @ w_attn_branch[l]
        branch_b = chunked_sgu(jax.nn.gelu(uv), w_spatial[l], b_spatial[l],
                               sgu_ln_g[l], sgu_ln_b[l]) @ w_sgu_branch[l]
        gates = jax.nn.sigmoid(gate_logits)
        merged = gates[..., :D_MODEL] * branch_a + gates[..., D_MODEL:] * branch_b
        x = x + merged @ w_out[l]
        h2 = rms_norm(x, ffn_norm[l])
        x = x + (jax.nn.silu(h2 @ w_gate[l]) * (h2 @ w_up[l])) @ w_down[l]
    return x
```

```cpp
#include <hip/hip_runtime.h>
#include <hip/hip_cooperative_groups.h>
#include <cstdio>
#include <cstdint>
namespace cg = cooperative_groups;

#ifndef MK_ONE_LAUNCH
#define MK_ONE_LAUNCH 1
#endif

namespace pg8 {
#define PG8_LAS __attribute__((address_space(3)))
typedef unsigned short bf16_t;
typedef short bf16x8 __attribute__((ext_vector_type(8)));
typedef float f32x4 __attribute__((ext_vector_type(4)));
typedef unsigned u32x4 __attribute__((ext_vector_type(4)));
typedef unsigned u32x2 __attribute__((ext_vector_type(2)));
constexpr int BM = 256, BK = 64, HALF = 128, HTB = HALF * BK * 2  , STAGE_BYTES = 8 * HTB, NXCD = 8, WGM = 4;

__host__ __device__ __forceinline__ int lds_byte(int r, int c) { const int st = (r >> 4) * 2 + (c >> 5), rr = r & 15, cc = c & 31, ob = rr * 64 + cc * 2; return st * 1024 + (ob ^ (((ob >> 9) & 1) << 5)); }
__host__ __device__ __forceinline__ void stage_rc(int b, int& R, int& C) { const int st = b / 1024, sb = b % 1024, swz = sb ^ (((sb >> 9) & 1) << 5); R = (st >> 1) * 16 + swz / 64; C = (st & 1) * 32 + (swz % 64) / 2; }
__host__ __device__ __forceinline__ int perm32(int rho) { const int n = rho >> 4, i = rho & 15; return 8 * (i >> 2) + 4 * n + (i & 3); }

struct Unit { int pm, pn, part; };
struct Gemm { const bf16_t* A; const bf16_t* Bt; const bf16_t* A1; const bf16_t* Bt1; int M, N, K; };

struct StaticOrder {
    int nM, nN, nwg, G, c, dual;
    __host__ __device__ void init(int M, int N, int G_, int c_, int dual_) { nM = M / BM; nN = N / BM; nwg = nM * nN; G = G_; c = c_; dual = dual_; }
    __host__ __device__ bool next(int i, Unit& u) const {
        const int ii = dual ? (i >> 1) : i; u.part = dual ? (i & 1) : 0;
        const long L = (long)ii * G + c; if (L >= nwg) return false;
        int wgid = (int)L; { const int q = nwg / NXCD, r = nwg % NXCD, xcd = wgid % NXCD, off = wgid / NXCD; wgid = (xcd < r ? xcd * (q + 1) : r * (q + 1) + (xcd - r) * q) + off; }
        const int nig = WGM * nN, gid = wgid / nig, fm = gid * WGM, gsz = (nM - fm) < WGM ? (nM - fm) : WGM;
        u.pm = fm + ((wgid % nig) % gsz); u.pn = (wgid % nig) / gsz; return true;
    }
    __device__ __forceinline__ void a_ready(const Unit&) const {}
    __device__ __forceinline__ void done(const Unit&) const {}
};

__device__ __forceinline__ unsigned cvt_pk_bf16(float lo, float hi) { unsigned r; asm volatile("v_cvt_pk_bf16_f32 %0, %1, %2" : "=v"(r) : "v"(lo), "v"(hi)); return r; }
__device__ __forceinline__ void st16_wt(void* p, u32x4 v) { asm volatile("global_store_dwordx4 %0, %1, off sc1\n\ts_nop 1" :: "v"(p), "v"(v) : "memory"); }
__device__ __forceinline__ float bf_lo(unsigned w) { return __uint_as_float(w << 16); }
__device__ __forceinline__ float bf_hi(unsigned w) { return __uint_as_float(w & 0xffff0000u); }
__device__ __forceinline__ float sigmoid_f(float v) { return __builtin_amdgcn_rcpf(1.0f + __expf(-v)); }
__device__ __forceinline__ float gelu_f(float x) { const float y2 = 1.5957691216057308f * x * (1.0f + 0.044715f * x * x); return x * sigmoid_f(y2); }

constexpr int D_MODEL = 2048, IN_W = 7680, D_FF = 5632, MROWS = 8192, SEQ = 2048;
constexpr int C_K = 1024, C_V = 1280, C_U = 1536, C_VS = 2560, C_GA = 3584, C_GB = 5632;
constexpr float EPS = 1e-6f;

struct EpiProj {
    static constexpr bool PERM = true, AFTER_DRAIN = false, CHAIN = false;
    bf16_t* O; const float* ssq; const PG8_LAS float* rs; int pm0;
    __device__ __forceinline__ void operator()(const f32x4 (&acc)[2][2][4][2], const Unit& u, int wr, int wc, int fr, int fq) const {
        const int row0 = u.pm * BM + wr * 64 + fr, col0 = u.pn * BM + wc * 32 + 8 * fq; const bool sig = u.pn >= 14;
        float rr[2][4];
        if (u.pm == pm0) {
#pragma unroll
            for (int ai = 0; ai < 2; ++ai)
#pragma unroll
                for (int m = 0; m < 4; ++m) rr[ai][m] = rs[ai * HALF + wr * 64 + m * 16 + fr];
        } else {
#pragma unroll
            for (int ai = 0; ai < 2; ++ai)
#pragma unroll
                for (int m = 0; m < 4; ++m) { const float* p = ssq + (size_t)(2 * fq) * MROWS + row0 + ai * HALF + m * 16; rr[ai][m] = p[0] + p[MROWS]; }
#pragma unroll
            for (int ai = 0; ai < 2; ++ai)
#pragma unroll
                for (int m = 0; m < 4; ++m) { float t = rr[ai][m]; t += __shfl_xor(t, 16); t += __shfl_xor(t, 32); rr[ai][m] = rsqrtf(t * (1.0f / D_MODEL) + EPS); }
        }
#pragma unroll
        for (int ai = 0; ai < 2; ++ai)
#pragma unroll
            for (int m = 0; m < 4; ++m) { const int row = row0 + ai * HALF + m * 16; const float r = rr[ai][m]; bf16_t* rowp = O + (size_t)row * IN_W + col0;
#pragma unroll
                for (int bj = 0; bj < 2; ++bj) { f32x4 v0 = acc[ai][bj][m][0] * r, v1 = acc[ai][bj][m][1] * r;
                    if (sig) {
#pragma unroll
                        for (int j = 0; j < 4; ++j) { v0[j] = sigmoid_f(v0[j]); v1[j] = sigmoid_f(v1[j]); } }
                    u32x4 w; w.x = cvt_pk_bf16(v0[0], v0[1]); w.y = cvt_pk_bf16(v0[2], v0[3]); w.z = cvt_pk_bf16(v1[0], v1[1]); w.w = cvt_pk_bf16(v1[2], v1[3]);
                    if (sig) st16_wt(rowp + bj * HALF, w); else *(u32x4*)(rowp + bj * HALF) = w; } }
    }
};
struct EpiMerge {
    static constexpr bool PERM = true, AFTER_DRAIN = false, CHAIN = true;
    const bf16_t* P; bf16_t* O;
    __device__ __forceinline__ void operator()(f32x4 (&acc)[2][2][4][2], const Unit& u, int wr, int wc, int fr, int fq) const {
        const int row0 = u.pm * BM + wr * 64 + fr, col0 = u.pn * BM + wc * 32 + 8 * fq;
#pragma unroll
        for (int ai = 0; ai < 2; ++ai)
#pragma unroll
            for (int mp = 0; mp < 2; ++mp) {
                u32x4 ga[2][2], gb[2][2];
#pragma unroll
                for (int mm = 0; mm < 2; ++mm)
#pragma unroll
                    for (int bj = 0; bj < 2; ++bj) { const bf16_t* gp = P + (size_t)(row0 + ai * HALF + (2 * mp + mm) * 16) * IN_W + col0 + bj * HALF;
                        gb[mm][bj] = *(const u32x4*)(gp + C_GB); ga[mm][bj] = *(const u32x4*)(gp + (u.part ? C_GB : C_GA)); }
#pragma unroll
                for (int mm = 0; mm < 2; ++mm)
#pragma unroll
                    for (int bj = 0; bj < 2; ++bj) { const int m = 2 * mp + mm, row = row0 + ai * HALF + m * 16, col = col0 + bj * HALF; const u32x4 a = ga[mm][bj], b = gb[mm][bj];
                        f32x4 a0, a1, b0, b1; a0[0] = bf_lo(a.x); a0[1] = bf_hi(a.x); a0[2] = bf_lo(a.y); a0[3] = bf_hi(a.y); a1[0] = bf_lo(a.z); a1[1] = bf_hi(a.z); a1[2] = bf_lo(a.w); a1[3] = bf_hi(a.w);
                        b0[0] = bf_lo(b.x); b0[1] = bf_hi(b.x); b0[2] = bf_lo(b.y); b0[3] = bf_hi(b.y); b1[0] = bf_lo(b.z); b1[1] = bf_hi(b.z); b1[2] = bf_lo(b.w); b1[3] = bf_hi(b.w);
#pragma unroll
                        for (int j = 0; j < 4; ++j) { b0[j] = fmaxf(b0[j], 1e-30f); b1[j] = fmaxf(b1[j], 1e-30f); }
                        if (u.part == 0) {
#pragma unroll
                            for (int j = 0; j < 4; ++j) { acc[ai][bj][m][0][j] *= a0[j] * __builtin_amdgcn_rcpf(b0[j]); acc[ai][bj][m][1][j] *= a1[j] * __builtin_amdgcn_rcpf(b1[j]); }
                        } else { const f32x4 v0 = acc[ai][bj][m][0] * b0, v1 = acc[ai][bj][m][1] * b1;
                            u32x4 w; w.x = cvt_pk_bf16(v0[0], v0[1]); w.y = cvt_pk_bf16(v0[2], v0[3]); w.z = cvt_pk_bf16(v1[0], v1[1]); w.w = cvt_pk_bf16(v1[2], v1[3]);
                            *(u32x4*)(O + (size_t)row * D_MODEL + col) = w; } } }
    }
};
struct EpiRes {
    static constexpr bool PERM = true, AFTER_DRAIN = false, CHAIN = false;
    float* Xout; bf16_t* XB; float* ssq_out; int aux; PG8_LAS float* red;
    __device__ __forceinline__ void operator()(const f32x4 (&acc)[2][2][4][2], const Unit& u, int wr, int wc, int fr, int fq) const {
        const int row0 = u.pm * BM + wr * 64 + fr, col0 = u.pn * BM + wc * 32 + 8 * fq;
#pragma unroll
        for (int ai = 0; ai < 2; ++ai) {
            u32x4 xw[4][2];
#pragma unroll
            for (int m = 0; m < 4; ++m)
#pragma unroll
                for (int bj = 0; bj < 2; ++bj) xw[m][bj] = *(const u32x4*)(XB + (size_t)(row0 + ai * HALF + m * 16) * D_MODEL + col0 + bj * HALF);
#pragma unroll
            for (int m = 0; m < 4; ++m) { const int row = row0 + ai * HALF + m * 16; float ss = 0.f;
#pragma unroll
                for (int bj = 0; bj < 2; ++bj) { const size_t o = (size_t)row * D_MODEL + col0 + bj * HALF; const u32x4 t = xw[m][bj];
                    f32x4 v0, v1; v0[0] = bf_lo(t.x); v0[1] = bf_hi(t.x); v0[2] = bf_lo(t.y); v0[3] = bf_hi(t.y); v1[0] = bf_lo(t.z); v1[1] = bf_hi(t.z); v1[2] = bf_lo(t.w); v1[3] = bf_hi(t.w);
                    v0 = v0 + acc[ai][bj][m][0]; v1 = v1 + acc[ai][bj][m][1];
                    if (aux) { u32x4 w; w.x = cvt_pk_bf16(v0[0], v0[1]); w.y = cvt_pk_bf16(v0[2], v0[3]); w.z = cvt_pk_bf16(v1[0], v1[1]); w.w = cvt_pk_bf16(v1[2], v1[3]);
                        *(u32x4*)(XB + o) = w;
                        ss += (v0[0] * v0[0] + v0[1] * v0[1]) + (v0[2] * v0[2] + v0[3] * v0[3]) + (v1[0] * v1[0] + v1[1] * v1[1]) + (v1[2] * v1[2] + v1[3] * v1[3]); }
                    else { *(f32x4*)(Xout + o) = v0; *(f32x4*)(Xout + o + 4) = v1; } }
                if (aux) { ss += __shfl_xor(ss, 16); ss += __shfl_xor(ss, 32); if (fq == 0) red[(ai * HALF + wr * 64 + m * 16 + fr) * 4 + wc] = ss; } } }
        if (aux) {
            asm volatile("s_waitcnt lgkmcnt(0)" ::: "memory"); __builtin_amdgcn_s_barrier(); asm volatile("" ::: "memory");
            const int t = (wr * 4 + wc) * 64 + fq * 16 + fr;
            if (t < BM) { const f32x4 p = *(const PG8_LAS f32x4*)(red + 4 * t); ssq_out[(size_t)u.pn * MROWS + u.pm * BM + t] = (p[0] + p[1]) + (p[2] + p[3]); }
        }
    }
};
struct EpiSwiglu {
    static constexpr bool PERM = true, AFTER_DRAIN = false, CHAIN = false;
    bf16_t* O; const float* ssq; const PG8_LAS float* rs; int pm0;
    __device__ __forceinline__ void operator()(const f32x4 (&acc)[2][2][4][2], const Unit& u, int wr, int wc, int fr, int fq) const {
        const int row0 = u.pm * BM + wr * 64 + fr, col0 = u.pn * HALF + wc * 32 + 8 * fq;
        float rr[2][4];
        if (u.pm == pm0) {
#pragma unroll
            for (int ai = 0; ai < 2; ++ai)
#pragma unroll
                for (int m = 0; m < 4; ++m) rr[ai][m] = rs[ai * HALF + wr * 64 + m * 16 + fr];
        } else {
#pragma unroll
            for (int ai = 0; ai < 2; ++ai)
#pragma unroll
                for (int m = 0; m < 4; ++m) { const float* p = ssq + (size_t)(2 * fq) * MROWS + row0 + ai * HALF + m * 16; rr[ai][m] = p[0] + p[MROWS]; }
#pragma unroll
            for (int ai = 0; ai < 2; ++ai)
#pragma unroll
                for (int m = 0; m < 4; ++m) { float t = rr[ai][m]; t += __shfl_xor(t, 16); t += __shfl_xor(t, 32); rr[ai][m] = rsqrtf(t * (1.0f / D_MODEL) + EPS); }
        }
#pragma unroll
        for (int ai = 0; ai < 2; ++ai)
#pragma unroll
            for (int m = 0; m < 4; ++m) { const int row = row0 + ai * HALF + m * 16; const float r = rr[ai][m];
                float o[8];
#pragma unroll
                for (int n = 0; n < 2; ++n)
#pragma unroll
                    for (int j = 0; j < 4; ++j) { const float g = acc[ai][0][m][n][j] * r, up = acc[ai][1][m][n][j] * r; o[4 * n + j] = g * sigmoid_f(g) * up; }
                u32x4 w; w.x = cvt_pk_bf16(o[0], o[1]); w.y = cvt_pk_bf16(o[2], o[3]); w.z = cvt_pk_bf16(o[4], o[5]); w.w = cvt_pk_bf16(o[6], o[7]);
                *(u32x4*)(O + (size_t)row * D_FF + col0) = w; }
    }
};

template <class Epi, class Sched, bool ALIGN_EPI = false, bool SP2 = false>
__device__ __forceinline__ void gemm_phase(PG8_LAS unsigned char* lds, const Gemm g, const Sched& S, const Epi& E) {
    int tid_ = threadIdx.x; asm volatile("" : "+v"(tid_));
    const int tid = tid_, wid = __builtin_amdgcn_readfirstlane(tid >> 6), lane = tid & 63, wr = wid >> 2, wc = wid & 3, fr = lane & 15, fq = lane >> 4;
    const int K = g.K, nt = K / BK;
    unsigned voffA[2], voffB[2];
#pragma unroll
    for (int i = 0; i < 2; ++i) { int R, C; stage_rc(tid * 16 + i * 8192, R, C); const int Rb = Epi::PERM ? ((R & ~31) + perm32(R & 31)) : R;
        voffA[i] = (unsigned)(R * K + C) * 2u; voffB[i] = (unsigned)(Rb * K + C) * 2u; }
    const size_t kstep = (size_t)(BK * 2);
    const size_t hstep = (size_t)HALF * K * 2;
    const size_t tstep = 2 * hstep;
    const unsigned ldsw = (unsigned)wid * 1024u;
    const int aoff = lds_byte(wr * 64 + fr, fq * 8), boff = lds_byte(wc * 32 + fr, fq * 8);
#define PG8_SA(b, h) (((b) * 2 + (h)) * HTB)
#define PG8_SB(b, h) ((4 + (b) * 2 + (h)) * HTB)
#define PG8_STAGE(bufoff, gbase, voff) do { _Pragma("unroll") for (int _i = 0; _i < 2; ++_i) \
        __builtin_amdgcn_global_load_lds((const unsigned*)((const char*)(gbase) + (voff)[_i]), (PG8_LAS unsigned*)(lds + (bufoff) + ldsw + _i * 8192), 16, 0, 0); } while (0)
#define PG8_LDA(dst, b, h) do { _Pragma("unroll") for (int m = 0; m < 4; ++m) _Pragma("unroll") for (int k = 0; k < 2; ++k) dst[m][k] = *(const PG8_LAS bf16x8*)(lds + PG8_SA(b, h) + aoff + m * 2048 + k * 1024); } while (0)
#define PG8_LDB(dst, b, h) do { _Pragma("unroll") for (int n = 0; n < 2; ++n) _Pragma("unroll") for (int k = 0; k < 2; ++k) dst[n][k] = *(const PG8_LAS bf16x8*)(lds + PG8_SB(b, h) + boff + n * 2048 + k * 1024); } while (0)
#define PG8_MMA(ai, bj, At, Bt) do { __builtin_amdgcn_s_setprio(1); _Pragma("unroll") for (int m = 0; m < 4; ++m) _Pragma("unroll") for (int n = 0; n < 2; ++n) _Pragma("unroll") for (int k = 0; k < 2; ++k) \
        acc[ai][bj][m][n] = __builtin_amdgcn_mfma_f32_16x16x32_bf16(Bt[n][k], At[m][k], acc[ai][bj][m][n], 0, 0, 0); __builtin_amdgcn_s_setprio(0); } while (0)
#define PG8_WAIT_V(n) asm volatile("s_waitcnt vmcnt(" #n ")" ::: "memory")
#define PG8_WAIT_L(n) asm volatile("s_waitcnt lgkmcnt(" #n ")" ::: "memory")
#define PG8_BAR __builtin_amdgcn_s_barrier()
#define PG8_SCHED __builtin_amdgcn_sched_barrier(0)
    Unit cur, nxt; int ui = 0;
    if (!S.next(0, cur)) return;
    f32x4 acc[2][2][4][2];
#pragma unroll
    for (int a = 0; a < 2; ++a)
#pragma unroll
        for (int b = 0; b < 2; ++b)
#pragma unroll
            for (int m = 0; m < 4; ++m)
#pragma unroll
                for (int n = 0; n < 2; ++n) acc[a][b][m][n] = (f32x4){0.f, 0.f, 0.f, 0.f};
    bf16x8 At[4][2], B0[2][2], B1[2][2];
    const char* cA = (const char*)(cur.part ? g.A1 : g.A) + (size_t)cur.pm * tstep; const char* cB = (const char*)(cur.part ? g.Bt1 : g.Bt) + (size_t)cur.pn * tstep;
    S.a_ready(cur);
    if constexpr (SP2) {
        PG8_STAGE(PG8_SB(0, 0), cB, voffB); PG8_STAGE(PG8_SB(0, 1), cB + hstep, voffB); PG8_STAGE(PG8_SA(0, 0), cA, voffA); PG8_STAGE(PG8_SA(0, 1), cA + hstep, voffA);
        if (wr == 1) PG8_BAR;
        PG8_WAIT_V(2); PG8_BAR;
        PG8_STAGE(PG8_SB(1, 0), cB + kstep, voffB); PG8_STAGE(PG8_SA(1, 0), cA + kstep, voffA); PG8_STAGE(PG8_SB(1, 1), cB + hstep + kstep, voffB);
        PG8_WAIT_V(6); PG8_BAR;
    } else {
        PG8_STAGE(PG8_SB(0, 0), cB, voffB); PG8_STAGE(PG8_SA(0, 0), cA, voffA); PG8_STAGE(PG8_SB(0, 1), cB + hstep, voffB); PG8_STAGE(PG8_SA(0, 1), cA + hstep, voffA);
        if (wr == 1) PG8_BAR;
        PG8_WAIT_V(4); PG8_BAR;
        PG8_STAGE(PG8_SB(1, 0), cB + kstep, voffB); PG8_STAGE(PG8_SA(1, 0), cA + kstep, voffA); PG8_STAGE(PG8_SB(1, 1), cB + hstep + kstep, voffB);
        PG8_WAIT_V(6); PG8_BAR;
    }
    for (;;) {
        const bool has_next = S.next(ui + 1, nxt);
        const char* nA = has_next ? (const char*)(nxt.part ? g.A1 : g.A) + (size_t)nxt.pm * tstep : cA; const char* nB = has_next ? (const char*)(nxt.part ? g.Bt1 : g.Bt) + (size_t)nxt.pn * tstep : cB;
        for (int t = 0; t < nt; t += 2) {
            const bool last = (t == nt - 2);
            const char* a1 = cA + (size_t)(t + 1) * kstep;
            const char* a2 = last ? nA : cA + (size_t)(t + 2) * kstep; const char* b2 = last ? nB : cB + (size_t)(t + 2) * kstep;
            const char* a3 = a2 + kstep; const char* b3 = b2 + kstep;
            if (last && has_next) S.a_ready(nxt);
            if constexpr (SP2) {
            PG8_LDB(B0, 0, 0); PG8_LDB(B1, 0, 1); PG8_SCHED; PG8_LDA(At, 0, 0); PG8_STAGE(PG8_SA(1, 1), a1 + hstep, voffA);
            PG8_WAIT_V(8); PG8_WAIT_L(0); PG8_BAR; PG8_MMA(0, 0, At, B0); PG8_MMA(0, 1, At, B1); PG8_BAR; PG8_SCHED;
            PG8_LDA(At, 0, 1); PG8_STAGE(PG8_SB(0, 0), b2, voffB); PG8_STAGE(PG8_SB(0, 1), b2 + hstep, voffB); PG8_STAGE(PG8_SA(0, 0), a2, voffA);
            PG8_WAIT_V(8); PG8_WAIT_L(0); PG8_BAR; PG8_MMA(1, 0, At, B0); PG8_MMA(1, 1, At, B1); PG8_BAR; PG8_SCHED;
            PG8_LDB(B0, 1, 0); PG8_LDB(B1, 1, 1); PG8_SCHED; PG8_LDA(At, 1, 0); PG8_STAGE(PG8_SA(0, 1), a2 + hstep, voffA);
            PG8_WAIT_V(8); PG8_WAIT_L(0); PG8_BAR; PG8_MMA(0, 0, At, B0); PG8_MMA(0, 1, At, B1); PG8_BAR; PG8_SCHED;
            PG8_LDA(At, 1, 1); PG8_STAGE(PG8_SB(1, 0), b3, voffB); PG8_STAGE(PG8_SB(1, 1), b3 + hstep, voffB); PG8_STAGE(PG8_SA(1, 0), a3, voffA);
            PG8_WAIT_V(8); PG8_WAIT_L(0); PG8_BAR; PG8_MMA(1, 0, At, B0); PG8_MMA(1, 1, At, B1); PG8_BAR; PG8_SCHED;
            } else {
            PG8_LDB(B0, 0, 0); PG8_SCHED; PG8_LDA(At, 0, 0); PG8_STAGE(PG8_SA(1, 1), a1 + hstep, voffA);
            PG8_WAIT_L(8); PG8_BAR; PG8_WAIT_L(0); PG8_MMA(0, 0, At, B0); PG8_BAR; PG8_SCHED;
            PG8_LDB(B1, 0, 1); PG8_STAGE(PG8_SB(0, 0), b2, voffB);
            PG8_BAR; PG8_WAIT_L(0); PG8_MMA(0, 1, At, B1); PG8_BAR;
            PG8_LDA(At, 0, 1); PG8_STAGE(PG8_SA(0, 0), a2, voffA);
            PG8_BAR; PG8_WAIT_L(0); PG8_MMA(1, 0, At, B0); PG8_BAR; PG8_SCHED;
            PG8_STAGE(PG8_SB(0, 1), b2 + hstep, voffB);
            PG8_WAIT_V(6); PG8_BAR; PG8_MMA(1, 1, At, B1); PG8_BAR;
            PG8_LDB(B0, 1, 0); PG8_SCHED; PG8_LDA(At, 1, 0); PG8_STAGE(PG8_SA(0, 1), a2 + hstep, voffA);
            PG8_WAIT_L(8); PG8_BAR; PG8_WAIT_L(0); PG8_MMA(0, 0, At, B0); PG8_BAR; PG8_SCHED;
            PG8_LDB(B1, 1, 1); PG8_STAGE(PG8_SB(1, 0), b3, voffB);
            PG8_BAR; PG8_WAIT_L(0); PG8_MMA(0, 1, At, B1); PG8_BAR;
            PG8_LDA(At, 1, 1); PG8_STAGE(PG8_SA(1, 0), a3, voffA);
            PG8_BAR; PG8_WAIT_L(0); PG8_MMA(1, 0, At, B0); PG8_BAR; PG8_SCHED;
            PG8_STAGE(PG8_SB(1, 1), b3 + hstep, voffB);
            PG8_WAIT_V(6); PG8_BAR; PG8_MMA(1, 1, At, B1); PG8_BAR;
            }
        }
        if constexpr (ALIGN_EPI) { if (wr == 0) PG8_BAR; }
        if constexpr (!Epi::AFTER_DRAIN) { E(acc, cur, wr, wc, fr, fq); S.done(cur); }
        if (!has_next) break;
        if (!(Epi::CHAIN && cur.part == 0)) {
#pragma unroll
        for (int a = 0; a < 2; ++a)
#pragma unroll
            for (int b = 0; b < 2; ++b)
#pragma unroll
                for (int m = 0; m < 4; ++m)
#pragma unroll
                    for (int n = 0; n < 2; ++n) acc[a][b][m][n] = (f32x4){0.f, 0.f, 0.f, 0.f};
        }
        cur = nxt; cA = nA; cB = nB; ++ui;
        if constexpr (ALIGN_EPI) { if (wr == 1) PG8_BAR; }
    }
    PG8_WAIT_V(0);
    if constexpr (!ALIGN_EPI) { if (wr == 0) PG8_BAR; }
    PG8_BAR;
    if constexpr (Epi::AFTER_DRAIN) { E.fused(acc, cur, wr, wc, fr, fq, lds, wid, lane); S.done(cur); }
#undef PG8_SA
#undef PG8_SB
#undef PG8_STAGE
#undef PG8_LDA
#undef PG8_LDB
#undef PG8_MMA
#undef PG8_WAIT_V
#undef PG8_WAIT_L
#undef PG8_BAR
#undef PG8_SCHED
}
}

using pg8::bf16_t; using pg8::bf16x8; using pg8::f32x4; using pg8::u32x4; using pg8::u32x2; using pg8::cvt_pk_bf16; using pg8::bf_lo; using pg8::bf_hi; using pg8::gelu_f;
#define LAS __attribute__((address_space(3)))
typedef short s16x4 __attribute__((ext_vector_type(4)));

constexpr int NTHREADS = 512, NWAVES = 8;
constexpr int LDS_BYTES = 147456;
constexpr int DEPTH = 2;
constexpr int NPHASES = 1 + 6 * DEPTH;
static_assert(DEPTH == 2, "the weight-conversion schedule (masks) is written for two layers");
constexpr size_t MiB = 1u << 20;
constexpr size_t WS_SSQ = 0;
constexpr size_t WS_COS = 256 * 1024, WS_SIN = 512 * 1024;
constexpr size_t WS_BAR = 768 * 1024, BAR_BYTES = 16384;
constexpr int LDS_CTL_OFF = 141312;
constexpr size_t WS_WIN = 2 * MiB, SZ_WIN = 30 * MiB;
constexpr size_t WS_WA = 62 * MiB, SZ_WA = 4 * MiB;
constexpr size_t WS_WB = 70 * MiB, SZ_WB = 4 * MiB;
constexpr size_t WS_WO = 78 * MiB, SZ_WO = 8 * MiB;
constexpr size_t WS_WGU = 94 * MiB, SZ_WGU = 44 * MiB;
constexpr size_t WS_WD = 182 * MiB, SZ_WD = 22 * MiB;
constexpr size_t WS_XB = 226 * MiB;
constexpr size_t WS_PROJ = 258 * MiB;
constexpr size_t WS_ATT = 378 * MiB;
constexpr size_t WS_SGU = 394 * MiB;
constexpr size_t WS_MRG = 410 * MiB;
constexpr size_t WS_TMP = 442 * MiB;
constexpr size_t WS_ACT = WS_PROJ;
constexpr size_t WS_PART = 506 * MiB;
constexpr size_t WS_END = 507 * MiB;

struct Args { const float* in[17]; float* out; unsigned char* ws; int ph_lo, ph_hi; };

__device__ __forceinline__ float wave_sum(float v) {
#pragma unroll
    for (int o = 1; o < 64; o <<= 1) v += __shfl_xor(v, o);
    return v;
}

__device__ __forceinline__ void tr_item(const float* __restrict__ W, int K, int N, bf16_t* WT, const float* __restrict__ kscale, int rowmode, int item, int lane) {
    const int nblk = N >> 5, kb = item / nblk, nb = item - kb * nblk;
    const int c = lane >> 3, q = lane & 7, k0 = kb * 64 + c * 8, n0 = nb * 32 + q * 4;
    f32x4 v[8];
#pragma unroll
    for (int i = 0; i < 8; ++i) v[i] = __builtin_nontemporal_load((const f32x4*)(W + (size_t)(k0 + i) * N + n0));
    if (kscale) { const f32x4 s0 = *(const f32x4*)(kscale + k0), s1 = *(const f32x4*)(kscale + k0 + 4);
#pragma unroll
        for (int i = 0; i < 4; ++i) { v[i] = v[i] * s0[i]; v[4 + i] = v[4 + i] * s1[i]; } }
    const int drow = rowmode == 0 ? n0 : (((n0 >> 7) << 8) + (n0 & 127) + (rowmode == 2 ? 128 : 0));
#pragma unroll
    for (int e = 0; e < 4; ++e) { u32x4 o; o.x = cvt_pk_bf16(v[0][e], v[1][e]); o.y = cvt_pk_bf16(v[2][e], v[3][e]); o.z = cvt_pk_bf16(v[4][e], v[5][e]); o.w = cvt_pk_bf16(v[6][e], v[7][e]);
        pg8::st16_wt(WT + (size_t)(drow + e) * K + k0, o); }
}

__device__ __forceinline__ void p0_prologue(const Args& a, int gw, int NGW, int lane, unsigned mask, bool do_x, unsigned fmask = 0u, int flo = 0, int fhi = 16) {
    unsigned char* ws = a.ws;
    int base = 0;
#pragma unroll 1
    for (int mi = 0; mi < 7 * DEPTH; ++mi) {
        if (!((mask >> mi) & 1u)) continue;
        const int l = mi / 7, kind = mi - 7 * l;
        const float* W; const float* ks = nullptr; bf16_t* WT; int K, N, rm = 0;
        if (kind == 0)      { W = a.in[2] + (size_t)l * 2048 * 7680;  K = 2048; N = 7680; WT = (bf16_t*)(ws + WS_WIN + l * SZ_WIN); ks = a.in[1] + l * 2048; }
        else if (kind == 1) { W = a.in[10] + (size_t)l * 1024 * 2048; K = 1024; N = 2048; WT = (bf16_t*)(ws + WS_WA + l * SZ_WA); }
        else if (kind == 2) { W = a.in[11] + (size_t)l * 1024 * 2048; K = 1024; N = 2048; WT = (bf16_t*)(ws + WS_WB + l * SZ_WB); }
        else if (kind == 3) { W = a.in[12] + (size_t)l * 2048 * 2048; K = 2048; N = 2048; WT = (bf16_t*)(ws + WS_WO + l * SZ_WO); }
        else if (kind == 4) { W = a.in[14] + (size_t)l * 2048 * 5632; K = 2048; N = 5632; WT = (bf16_t*)(ws + WS_WGU + l * SZ_WGU); ks = a.in[13] + l * 2048; rm = 1; }
        else if (kind == 5) { W = a.in[15] + (size_t)l * 2048 * 5632; K = 2048; N = 5632; WT = (bf16_t*)(ws + WS_WGU + l * SZ_WGU); ks = a.in[13] + l * 2048; rm = 2; }
        else                { W = a.in[16] + (size_t)l * 5632 * 2048; K = 5632; N = 2048; WT = (bf16_t*)(ws + WS_WD + l * SZ_WD); }
        const int nitems = (K >> 6) * (N >> 5);
        int ilo = 0, ihi = nitems; if ((fmask >> mi) & 1u) { ilo = (nitems * flo) >> 4; ihi = (nitems * fhi) >> 4; }
        const int cnt = ihi - ilo;
        int first = (gw - base) % NGW; if (first < 0) first += NGW;
        for (int it = first; it < cnt; it += NGW) tr_item(W, K, N, WT, ks, rm, ilo + it, lane);
        base = (base + cnt) % NGW;
    }
    if (!do_x) return;
    const float* x = a.in[0]; bf16_t* XB = (bf16_t*)(ws + WS_XB); float* SSQ = (float*)(ws + WS_PART);
    for (int row = gw; row < pg8::MROWS; row += NGW) {
        const f32x4* xr = (const f32x4*)(x + (size_t)row * 2048) + lane; u32x2* xo = (u32x2*)(XB + (size_t)row * 2048) + lane; float ss = 0.f;
#pragma unroll
        for (int j = 0; j < 8; ++j) { const f32x4 v = xr[64 * j]; ss += (v[0] * v[0] + v[1] * v[1]) + (v[2] * v[2] + v[3] * v[3]); u32x2 o; o.x = cvt_pk_bf16(v[0], v[1]); o.y = cvt_pk_bf16(v[2], v[3]); xo[64 * j] = o; }
        ss = wave_sum(ss); if (lane < 8) SSQ[(size_t)lane * pg8::MROWS + row] = lane == 0 ? ss : 0.f;
    }
    const int gt = gw * 64 + lane, NGT = NGW * 64;
    float* COS = (float*)(ws + WS_COS); float* SIN = (float*)(ws + WS_SIN);
    for (int i = gt; i < pg8::SEQ * 32; i += NGT) {
        const int pos = i >> 5, f = i & 31;
        float invf = 1.0f; { float m8 = 1.0f;
            const int hi = f >> 3, lo = f & 7; const double c1 = 0.7498942093324559; double p = 1.0; for (int t = 0; t < lo; ++t) p *= c1; double d = 1.0; for (int t = 0; t < hi; ++t) d *= 0.1; invf = (float)(p * d); (void)m8; }
        const float angf = (float)pos * invf;
        const double ang = (double)angf;
        const double qd = __builtin_rint(ang * 0.6366197723675814); const int qi = (int)qd;
        const double r = (ang - qd * 1.5707963267948966) - qd * 6.123233995736766e-17, r2 = r * r;
        double sp = r * (1.0 + r2 * (-1.0 / 6 + r2 * (1.0 / 120 + r2 * (-1.0 / 5040 + r2 * (1.0 / 362880 + r2 * (-1.0 / 39916800 + r2 * (1.0 / 6227020800.0 + r2 * (-1.0 / 1307674368000.0))))))));
        double cp = 1.0 + r2 * (-0.5 + r2 * (1.0 / 24 + r2 * (-1.0 / 720 + r2 * (1.0 / 40320 + r2 * (-1.0 / 3628800 + r2 * (1.0 / 479001600 + r2 * (-1.0 / 87178291200.0 + r2 * (1.0 / 20922789888000.0))))))));
        double s, c; switch (qi & 3) { case 0: s = sp; c = cp; break; case 1: s = cp; c = -sp; break; case 2: s = -sp; c = -cp; break; default: s = -cp; c = sp; break; }
        COS[i] = (float)c; SIN[i] = (float)s;
    }
}

constexpr int KS_STRIDE = 144, VT_STRIDE = 528, KS_BYTES = 256 * KS_STRIDE, VT_BYTES = 64 * VT_STRIDE, VN_STRIDE = 272, VN_OFF0 = 71680, VN_BYTES = 128 * VN_STRIDE, VN_OFF1 = VN_OFF0 + VN_BYTES;
static_assert(KS_BYTES + VT_BYTES <= VN_OFF0 && VN_OFF1 + VN_BYTES <= LDS_CTL_OFF, "P2 LDS map");
#define MFMA16(a, b, c) __builtin_amdgcn_mfma_f32_16x16x32_bf16((a), (b), (c), 0, 0, 0)
__device__ __forceinline__ void unpack8(const u32x4 w, float* f) { f[0] = bf_lo(w.x); f[1] = bf_hi(w.x); f[2] = bf_lo(w.y); f[3] = bf_hi(w.y); f[4] = bf_lo(w.z); f[5] = bf_hi(w.z); f[6] = bf_lo(w.w); f[7] = bf_hi(w.w); }

__device__ __forceinline__ void p2_block(LAS unsigned char* lds, const bf16_t* __restrict__ PROJ, bf16_t* __restrict__ ATT, bf16_t* __restrict__ SGU, const float* __restrict__ qn, const float* __restrict__ kn,
                                         const float* __restrict__ sinks, const float* __restrict__ COS, const float* __restrict__ SIN, const float* __restrict__ lng, const float* __restrict__ lnb,
                                         const float* __restrict__ wsp, const float* __restrict__ bsp, int item, int tid) {
    asm volatile("" : "+v"(tid));
    const int b = item >> 6, n = (item >> 2) & 15, kvh = item & 3;
    const int lane = tid & 63, w = __builtin_amdgcn_readfirstlane(tid >> 6), fr = lane & 15, fq = lane >> 4;
    LAS unsigned char* KS = lds; LAS unsigned char* VT = lds + KS_BYTES;
    const int g = w >> 1, rbase = (w & 1) * 64, hq = kvh * 4 + g;
    const int kk = tid >> 1, h = tid & 1, s = n * 128 - 128 + kk, sc = s < 0 ? 0 : s;
    const bf16_t* rowp = PROJ + (size_t)(b * pg8::SEQ + sc) * pg8::IN_W;
    const bf16_t* kp = rowp + pg8::C_K + kvh * 64 + 16 * h;
    const u32x4 ka = *(const u32x4*)kp, kb = *(const u32x4*)(kp + 8), kc = *(const u32x4*)(kp + 32), kd = *(const u32x4*)(kp + 40);
    const bf16_t* vp = rowp + pg8::C_V + kvh * 64 + 32 * h;
    u32x4 vv[4];
#pragma unroll
    for (int c4 = 0; c4 < 4; ++c4) vv[c4] = *(const u32x4*)(vp + 8 * c4);
    const int sp_ = tid >> 2, q4 = tid & 3;
    u32x4 sv[2][4];
    const bf16_t* svsrc = PROJ + ((size_t)b * pg8::SEQ + n * 128 + sp_) * pg8::IN_W + pg8::C_VS + (2 * kvh) * 128 + 32 * q4;
#pragma unroll
    for (int c4 = 0; c4 < 4; ++c4) sv[0][c4] = *(const u32x4*)(svsrc + 8 * c4);
    u32x4 qa[4], qb[4];
#pragma unroll
    for (int c = 0; c < 2; ++c) { const bf16_t* qp = PROJ + ((size_t)b * pg8::SEQ + n * 128 + rbase + 16 * c + fr) * pg8::IN_W + hq * 64 + 8 * fq; qa[c] = *(const u32x4*)qp; qb[c] = *(const u32x4*)(qp + 32); }
    {
        const float valid = s < 0 ? 0.f : 1.f;
        float x1[16], x2[16]; unpack8(ka, x1); unpack8(kb, x1 + 8); unpack8(kc, x2); unpack8(kd, x2 + 8);
        float ss = 0.f;
#pragma unroll
        for (int j = 0; j < 16; ++j) ss += x1[j] * x1[j] + x2[j] * x2[j];
        ss += __shfl_xor(ss, 1);
        const float rinv = rsqrtf(ss * (1.0f / 64.0f) + pg8::EPS) * valid;
        const float* cp = COS + sc * 32 + 16 * h; const float* sp = SIN + sc * 32 + 16 * h;
        float o1[16], o2[16];
#pragma unroll
        for (int j = 0; j < 16; ++j) { const float a1 = x1[j] * rinv * kn[16 * h + j], a2 = x2[j] * rinv * kn[32 + 16 * h + j], c = cp[j], sn = sp[j]; o1[j] = a1 * c - a2 * sn; o2[j] = a2 * c + a1 * sn; }
        LAS unsigned char* kdst = KS + kk * KS_STRIDE + 32 * h;
        u32x4 w0, w1;
        w0.x = cvt_pk_bf16(o1[0], o1[1]); w0.y = cvt_pk_bf16(o1[2], o1[3]); w0.z = cvt_pk_bf16(o1[4], o1[5]); w0.w = cvt_pk_bf16(o1[6], o1[7]);
        w1.x = cvt_pk_bf16(o1[8], o1[9]); w1.y = cvt_pk_bf16(o1[10], o1[11]); w1.z = cvt_pk_bf16(o1[12], o1[13]); w1.w = cvt_pk_bf16(o1[14], o1[15]);
        *(LAS u32x4*)kdst = w0; *(LAS u32x4*)(kdst + 16) = w1;
        w0.x = cvt_pk_bf16(o2[0], o2[1]); w0.y = cvt_pk_bf16(o2[2], o2[3]); w0.z = cvt_pk_bf16(o2[4], o2[5]); w0.w = cvt_pk_bf16(o2[6], o2[7]);
        w1.x = cvt_pk_bf16(o2[8], o2[9]); w1.y = cvt_pk_bf16(o2[10], o2[11]); w1.z = cvt_pk_bf16(o2[12], o2[13]); w1.w = cvt_pk_bf16(o2[14], o2[15]);
        *(LAS u32x4*)(kdst + 64) = w0; *(LAS u32x4*)(kdst + 80) = w1;
#pragma unroll
        for (int c4 = 0; c4 < 4; ++c4) { u32x4 t = vv[c4]; if (s < 0) t = (u32x4){0u, 0u, 0u, 0u};
            LAS unsigned char* vd = VT + (32 * h + 8 * c4) * VT_STRIDE + kk * 2;
            *(LAS unsigned short*)(vd + 0 * VT_STRIDE) = (unsigned short)(t.x & 0xffffu); *(LAS unsigned short*)(vd + 1 * VT_STRIDE) = (unsigned short)(t.x >> 16);
            *(LAS unsigned short*)(vd + 2 * VT_STRIDE) = (unsigned short)(t.y & 0xffffu); *(LAS unsigned short*)(vd + 3 * VT_STRIDE) = (unsigned short)(t.y >> 16);
            *(LAS unsigned short*)(vd + 4 * VT_STRIDE) = (unsigned short)(t.z & 0xffffu); *(LAS unsigned short*)(vd + 5 * VT_STRIDE) = (unsigned short)(t.z >> 16);
            *(LAS unsigned short*)(vd + 6 * VT_STRIDE) = (unsigned short)(t.w & 0xffffu); *(LAS unsigned short*)(vd + 7 * VT_STRIDE) = (unsigned short)(t.w >> 16); }
    }
#pragma unroll
    for (int gi = 0; gi < 2; ++gi) {
        const int gg = 2 * kvh + gi;
        if (gi == 0) {
#pragma unroll
            for (int c4 = 0; c4 < 4; ++c4) sv[1][c4] = *(const u32x4*)(svsrc + 128 + 8 * c4); }
        float v[32];
#pragma unroll
        for (int c4 = 0; c4 < 4; ++c4) unpack8(sv[gi][c4], v + 8 * c4);
        float sm = 0.f;
#pragma unroll
        for (int j = 0; j < 32; ++j) { v[j] = gelu_f(v[j]); sm += v[j]; }
        sm += __shfl_xor(sm, 1); sm += __shfl_xor(sm, 2);
        const float mu = sm * (1.0f / 128.0f); float q = 0.f;
#pragma unroll
        for (int j = 0; j < 32; ++j) { v[j] -= mu; q += v[j] * v[j]; }
        q += __shfl_xor(q, 1); q += __shfl_xor(q, 2);
        const float rstd = rsqrtf(q * (1.0f / 128.0f) + pg8::EPS);
        const float* gp = lng + gg * 128 + 32 * q4; const float* bp = lnb + gg * 128 + 32 * q4;
        LAS unsigned char* dst = lds + (gi ? VN_OFF1 : VN_OFF0) + (32 * q4) * VN_STRIDE + sp_ * 2;
#pragma unroll
        for (int j = 0; j < 32; j += 2) { const unsigned pk = cvt_pk_bf16(v[j] * rstd * gp[j] + bp[j], v[j + 1] * rstd * gp[j + 1] + bp[j + 1]);
            *(LAS unsigned short*)(dst + j * VN_STRIDE) = (unsigned short)(pk & 0xffffu); *(LAS unsigned short*)(dst + (j + 1) * VN_STRIDE) = (unsigned short)(pk >> 16); }
    }
    __syncthreads();
#pragma unroll
    for (int c = 2; c < 4; ++c) { const bf16_t* qp = PROJ + ((size_t)b * pg8::SEQ + n * 128 + rbase + 16 * c + fr) * pg8::IN_W + hq * 64 + 8 * fq; qa[c] = *(const u32x4*)qp; qb[c] = *(const u32x4*)(qp + 32); }
    const float sink = sinks[hq];
    constexpr float LOG2E = 1.4426950408889634f;
#pragma unroll
    for (int c = 0; c < 4; ++c) {
        const int i0 = rbase + 16 * c, irow = i0 + fr, pos = n * 128 + irow; const size_t grow = (size_t)b * pg8::SEQ + pos;
        bf16x8 qf0, qf1;
        {
            float x1[8], x2[8]; unpack8(qa[c], x1); unpack8(qb[c], x2);
            float ss = 0.f;
#pragma unroll
            for (int j = 0; j < 8; ++j) ss += x1[j] * x1[j] + x2[j] * x2[j];
            ss += __shfl_xor(ss, 16); ss += __shfl_xor(ss, 32);
            const float rinv = rsqrtf(ss * (1.0f / 64.0f) + pg8::EPS) * 0.125f;
            const float* cp = COS + pos * 32 + 8 * fq; const float* sp = SIN + pos * 32 + 8 * fq;
            float o1[8], o2[8];
#pragma unroll
            for (int j = 0; j < 8; ++j) { const float a1 = x1[j] * rinv * qn[8 * fq + j], a2 = x2[j] * rinv * qn[32 + 8 * fq + j], cc = cp[j], sn = sp[j]; o1[j] = a1 * cc - a2 * sn; o2[j] = a2 * cc + a1 * sn; }
            u32x4 w0, w1;
            w0.x = cvt_pk_bf16(o1[0], o1[1]); w0.y = cvt_pk_bf16(o1[2], o1[3]); w0.z = cvt_pk_bf16(o1[4], o1[5]); w0.w = cvt_pk_bf16(o1[6], o1[7]);
            w1.x = cvt_pk_bf16(o2[0], o2[1]); w1.y = cvt_pk_bf16(o2[2], o2[3]); w1.z = cvt_pk_bf16(o2[4], o2[5]); w1.w = cvt_pk_bf16(o2[6], o2[7]);
            qf0 = __builtin_bit_cast(bf16x8, w0); qf1 = __builtin_bit_cast(bf16x8, w1);
        }
        const int t0 = (i0 >> 4) < 6 ? (i0 >> 4) : 6;
        f32x4 sc_[10];
        const LAS unsigned char* kbase = KS + (16 * t0 + fr) * KS_STRIDE + 16 * fq;
#pragma unroll
        for (int t = 0; t < 10; ++t) { const bf16x8 k0 = *(const LAS bf16x8*)(kbase + t * 16 * KS_STRIDE), k1 = *(const LAS bf16x8*)(kbase + t * 16 * KS_STRIDE + 64);
            f32x4 z = (f32x4){0.f, 0.f, 0.f, 0.f}; z = MFMA16(k0, qf0, z); sc_[t] = MFMA16(k1, qf1, z); }
        float mx = -1e30f;
#pragma unroll
        for (int t = 0; t < 10; ++t)
#pragma unroll
            for (int e = 0; e < 4; ++e) { const int kx = 16 * (t0 + t) + 4 * fq + e, d = kx - irow; const bool ok = (d >= 1) && (d <= 128) && (n > 0 || kx >= 128);
                const float v = ok ? sc_[t][e] : -1e30f; sc_[t][e] = v; mx = fmaxf(mx, v); }
        mx = fmaxf(mx, __shfl_xor(mx, 16)); mx = fmaxf(mx, __shfl_xor(mx, 32)); mx = fmaxf(mx, sink);
        float sum = 0.f;
#pragma unroll
        for (int t = 0; t < 10; ++t)
#pragma unroll
            for (int e = 0; e < 4; ++e) { const float p = __builtin_amdgcn_exp2f((sc_[t][e] - mx) * LOG2E); sc_[t][e] = p; sum += p; }
        sum += __shfl_xor(sum, 16); sum += __shfl_xor(sum, 32);
        const float inv = 1.0f / (sum + __builtin_amdgcn_exp2f((sink - mx) * LOG2E));
        f32x4 o[4];
#pragma unroll
        for (int dt = 0; dt < 4; ++dt) o[dt] = (f32x4){0.f, 0.f, 0.f, 0.f};
#pragma unroll
        for (int j = 0; j < 5; ++j) {
            u32x4 pw; pw.x = cvt_pk_bf16(sc_[2 * j][0], sc_[2 * j][1]); pw.y = cvt_pk_bf16(sc_[2 * j][2], sc_[2 * j][3]); pw.z = cvt_pk_bf16(sc_[2 * j + 1][0], sc_[2 * j + 1][1]); pw.w = cvt_pk_bf16(sc_[2 * j + 1][2], sc_[2 * j + 1][3]);
            const bf16x8 pf = __builtin_bit_cast(bf16x8, pw);
#pragma unroll
            for (int dt = 0; dt < 4; ++dt) { const LAS unsigned char* vb = VT + (16 * dt + fr) * VT_STRIDE + (16 * (t0 + 2 * j) + 4 * fq) * 2;
                const u32x2 va = *(const LAS u32x2*)vb, vc = *(const LAS u32x2*)(vb + 32); u32x4 vw; vw.x = va.x; vw.y = va.y; vw.z = vc.x; vw.w = vc.y;
                o[dt] = MFMA16(__builtin_bit_cast(bf16x8, vw), pf, o[dt]); }
        }
        bf16_t* op = ATT + grow * 1024 + hq * 64 + 4 * fq;
#pragma unroll
        for (int dt = 0; dt < 4; ++dt) { u32x2 ow; ow.x = cvt_pk_bf16(o[dt][0] * inv, o[dt][1] * inv); ow.y = cvt_pk_bf16(o[dt][2] * inv, o[dt][3] * inv); *(u32x2*)(op + 16 * dt) = ow; }
    }
#pragma unroll
    for (int gi = 0; gi < 2; ++gi) {
        const int gg = 2 * kvh + gi, irow = 16 * w + fr, nks = (w >> 1) + 1;
        const LAS unsigned char* VNT = lds + (gi ? VN_OFF1 : VN_OFF0);
        f32x4 acc[8];
#pragma unroll
        for (int dt = 0; dt < 8; ++dt) acc[dt] = (f32x4){0.f, 0.f, 0.f, 0.f};
        const float* wrow = wsp + (size_t)gg * 16384 + irow * 128 + 8 * fq;
#pragma unroll
        for (int ks = 0; ks < 4; ++ks) if (ks < nks) {
            const f32x4 wa = *(const f32x4*)(wrow + 32 * ks), wb = *(const f32x4*)(wrow + 32 * ks + 4);
            const int j0 = 32 * ks + 8 * fq; float wv[8];
#pragma unroll
            for (int e = 0; e < 4; ++e) { wv[e] = (j0 + e <= irow) ? wa[e] : 0.f; wv[4 + e] = (j0 + 4 + e <= irow) ? wb[e] : 0.f; }
            u32x4 ww; ww.x = cvt_pk_bf16(wv[0], wv[1]); ww.y = cvt_pk_bf16(wv[2], wv[3]); ww.z = cvt_pk_bf16(wv[4], wv[5]); ww.w = cvt_pk_bf16(wv[6], wv[7]);
            const bf16x8 wf = __builtin_bit_cast(bf16x8, ww);
#pragma unroll
            for (int dt = 0; dt < 8; ++dt) { const bf16x8 af = *(const LAS bf16x8*)(VNT + (16 * dt + fr) * VN_STRIDE + (32 * ks + 8 * fq) * 2); acc[dt] = MFMA16(af, wf, acc[dt]); }
        }
        const float bias = bsp[gg * 128 + irow];
        const size_t grow = (size_t)b * pg8::SEQ + n * 128 + irow;
        const bf16_t* up = PROJ + grow * pg8::IN_W + pg8::C_U + gg * 128 + 4 * fq; bf16_t* op = SGU + grow * 1024 + gg * 128 + 4 * fq;
#pragma unroll
        for (int dt = 0; dt < 8; ++dt) { const u32x2 uw = *(const u32x2*)(up + 16 * dt);
            const float u0 = gelu_f(bf_lo(uw.x)), u1 = gelu_f(bf_hi(uw.x)), u2 = gelu_f(bf_lo(uw.y)), u3 = gelu_f(bf_hi(uw.y));
            u32x2 ow; ow.x = cvt_pk_bf16(u0 * (acc[dt][0] + bias), u1 * (acc[dt][1] + bias)); ow.y = cvt_pk_bf16(u2 * (acc[dt][2] + bias), u3 * (acc[dt][3] + bias)); *(u32x2*)(op + 16 * dt) = ow; }
    }
    __syncthreads();
}

#define XB_TMO      128
#define XB_XCNT(j)  (256  + 64 * (j))
#define XB_XSUB(j)  (1280 + 64 * (j))
#define XB_XGEN(j)  (2304 + 64 * (j))
#define XB_TOP      3328
#define XB_TOPGEN   3392
#define XCD_BAR_WORDS 3456
#define XB_SPIN_CAP (1u << 18)

__device__ __forceinline__ unsigned xb_ld(unsigned* p)              { return __hip_atomic_load(p, __ATOMIC_RELAXED, __HIP_MEMORY_SCOPE_AGENT); }
__device__ __forceinline__ unsigned xb_add(unsigned* p, unsigned v) { return __hip_atomic_fetch_add(p, v, __ATOMIC_RELAXED, __HIP_MEMORY_SCOPE_AGENT); }
__device__ __forceinline__ unsigned xb_xcc_id() { return (unsigned)__builtin_amdgcn_s_getreg((3 << 11) | 20) & 0xFu; }
#define XB_SPIN(cond, bar) do { unsigned _sp = 0; while (cond) { __builtin_amdgcn_s_sleep(1); \
    if ((++_sp & 255u) == 0u) { if (xb_ld(&(bar)[XB_TMO])) break; if (_sp > XB_SPIN_CAP) { atomicAdd(&(bar)[XB_TMO], 1u); break; } } } } while (0)

struct XcdBarrier {
    unsigned* bar; unsigned x;
    volatile LAS unsigned* st;
};

__device__ __forceinline__ XcdBarrier xcd_barrier_post(unsigned* bar, volatile LAS unsigned* st) {
    XcdBarrier b; b.bar = bar; b.x = xb_xcc_id(); b.st = st;
    if (threadIdx.x == 0) (void)xb_add(&bar[XB_XCNT(b.x)], 1u);
    return b;
}
__device__ __forceinline__ void xcd_barrier_complete(unsigned* bar, unsigned x, unsigned& nloc, unsigned& nx) {
    const unsigned G = gridDim.x * gridDim.y * gridDim.z;
    unsigned sum, cnt, mine, sp = 0u;
    for (;;) {
        sum = 0u; cnt = 0u; mine = 0u;
#pragma unroll
        for (unsigned j = 0; j < 16; ++j) { const unsigned c = xb_ld(&bar[XB_XCNT(j)]); sum += c; cnt += (c > 0u) ? 1u : 0u; mine = (j == x) ? c : mine; }
        if (sum == G) break;
        __builtin_amdgcn_s_sleep(1);
        if ((++sp & 255u) == 0u) { if (xb_ld(&bar[XB_TMO])) break; if (sp > XB_SPIN_CAP) { atomicAdd(&bar[XB_TMO], 1u); break; } }
    }
    nloc = mine > 0u ? mine : 1u; nx = cnt > 0u ? cnt : 1u;
}

__device__ __forceinline__ void xcd_barrier(const XcdBarrier& b) {
    asm volatile("s_waitcnt vmcnt(0)" ::: "memory");
    __syncthreads();
    if (threadIdx.x == 0) {
        unsigned* bar = b.bar;
        __builtin_amdgcn_s_waitcnt(0);
        unsigned nloc = b.st[0], nx = b.st[1];
        if (nloc == 0u) { xcd_barrier_complete(bar, b.x, nloc, nx); b.st[0] = nloc; b.st[1] = nx; }
        const unsigned old = xb_add(&bar[XB_XSUB(b.x)], 1u);
        const unsigned gen = old / nloc;
        if (old + 1u == (gen + 1u) * nloc) {
            __builtin_amdgcn_fence(__ATOMIC_RELEASE, "agent");
            asm volatile("s_waitcnt vmcnt(0)" ::: "memory");
            const unsigned og = xb_add(&bar[XB_TOP], 1u);
            const unsigned tg = og / nx;
            if (og + 1u == (tg + 1u) * nx) xb_add(&bar[XB_TOPGEN], 1u);
            else XB_SPIN(xb_ld(&bar[XB_TOPGEN]) == tg, bar);
            __builtin_amdgcn_fence(__ATOMIC_ACQUIRE, "agent");
            xb_add(&bar[XB_XGEN(b.x)], 1u);
            asm volatile("s_waitcnt vmcnt(0)" ::: "memory");
        } else {
            __builtin_amdgcn_fence(__ATOMIC_ACQUIRE, "agent");
            asm volatile("s_waitcnt vmcnt(0)" ::: "memory");
            XB_SPIN(xb_ld(&bar[XB_XGEN(b.x)]) == gen, bar);
            asm volatile("" ::: "memory");
            asm volatile("s_waitcnt vmcnt(0)" ::: "memory");
        }
    }
    __syncthreads();
}


__device__ __forceinline__ void build_row_scale(LAS float* rs, const float* part, int pm, int tid) {
    if (tid < 256) { float t = 0.f;
#pragma unroll
        for (int j = 0; j < 8; ++j) t += part[(size_t)j * pg8::MROWS + pm * 256 + tid];
        rs[tid] = rsqrtf(t * (1.0f / pg8::D_MODEL) + pg8::EPS); }
    __syncthreads();
}

__global__ void __launch_bounds__(NTHREADS, 2) mk_fwd(Args args) {
    extern __shared__ __attribute__((aligned(16))) unsigned char lds_raw[];
    LAS unsigned char* lds = (LAS unsigned char*)lds_raw;
    const int tid = threadIdx.x, lane = tid & 63, wave = __builtin_amdgcn_readfirstlane(tid >> 6);
    const int G = gridDim.x, blk = blockIdx.x;
    unsigned char* ws = args.ws;
    const int lo = args.ph_lo, hi = args.ph_hi;
#define IN(k) (lo <= (k) && (k) < hi)
#ifndef PH_MASK
#define PH_MASK 127
#endif
#define KON(kind) (((PH_MASK) >> (kind)) & 1)
#define SEAM(k) do { if (IN(k) && IN((k) + 1)) { if (hi > 4096) cg::this_grid().sync(); else xcd_barrier(bar); } } while (0)
    for (int u = tid; u < 64; u += NTHREADS) ((LAS unsigned*)(lds + LDS_CTL_OFF))[u] = 0u;
    __syncthreads();
    const XcdBarrier bar = xcd_barrier_post((unsigned*)(ws + WS_BAR), (volatile LAS unsigned*)(lds + LDS_CTL_OFF + 32));
    float* SSQ = (float*)(ws + WS_PART); PG8_LAS float* RED = (PG8_LAS float*)(lds + LDS_CTL_OFF + 1024); LAS float* RS = (LAS float*)(lds + LDS_CTL_OFF + 5120); const float* COS = (const float*)(ws + WS_COS); const float* SIN = (const float*)(ws + WS_SIN);
    bf16_t* XB = (bf16_t*)(ws + WS_XB); bf16_t* PROJ = (bf16_t*)(ws + WS_PROJ); bf16_t* ATT = (bf16_t*)(ws + WS_ATT); bf16_t* SGU = (bf16_t*)(ws + WS_SGU);
    bf16_t* MRG = (bf16_t*)(ws + WS_MRG); bf16_t* TMP = (bf16_t*)(ws + WS_TMP); bf16_t* ACT = (bf16_t*)(ws + WS_ACT);

    if (KON(0) && IN(0)) { const int vcu = (G % 8 == 0) ? (blk % 8) * (G / 8) + blk / 8 : blk; p0_prologue(args, vcu * NWAVES + wave, G * NWAVES, lane, 0x000Fu | 0x0010u | 0x0800u, true, 0x0810u, 0, 10); }
    SEAM(0);
#pragma unroll 1
    for (int l = 0; l < DEPTH; ++l) {
        const int pb = 1 + 6 * l;
        const bf16_t* WIN = (const bf16_t*)(ws + WS_WIN + l * SZ_WIN); const bf16_t* WA = (const bf16_t*)(ws + WS_WA + l * SZ_WA); const bf16_t* WB = (const bf16_t*)(ws + WS_WB + l * SZ_WB);
        const bf16_t* WO = (const bf16_t*)(ws + WS_WO + l * SZ_WO); const bf16_t* WGU = (const bf16_t*)(ws + WS_WGU + l * SZ_WGU); const bf16_t* WD = (const bf16_t*)(ws + WS_WD + l * SZ_WD);
        if (KON(1) && IN(pb + 0)) {
            pg8::Gemm g{XB, WIN, XB, WIN, pg8::MROWS, pg8::IN_W, 2048}; pg8::StaticOrder S; S.init(pg8::MROWS, pg8::IN_W, G, blk, 0);
            pg8::Unit u0; const int pm0 = S.next(0, u0) ? u0.pm : -1; if (pm0 >= 0) build_row_scale(RS, SSQ + (size_t)(2 * l) * 8 * pg8::MROWS, pm0, tid);
            pg8::EpiProj E{PROJ, SSQ + (size_t)(2 * l) * 8 * pg8::MROWS, RS, pm0};
            pg8::gemm_phase<pg8::EpiProj, pg8::StaticOrder, true, true>(lds, g, S, E);
            { int thr = S.nwg - ((S.nwg + G - 1) / G - 1) * G; if (thr >= G) thr = 0;
                if (blk >= thr) p0_prologue(args, (blk - thr) * NWAVES + wave, (G - thr) * NWAVES, lane, l == 0 ? 0x0030u : 0x1800u, false, l == 0 ? 0x0010u : 0x0800u, 10, 16); }
        }
        SEAM(pb + 0);
        if (KON(2) && IN(pb + 1)) {
            for (int it = blk; it < 256; it += G) p2_block(lds, PROJ, ATT, SGU, args.in[3] + l * 64, args.in[4] + l * 64, args.in[5] + l * 16, COS, SIN, args.in[6] + l * 1024, args.in[7] + l * 1024,
                                                           args.in[8] + (size_t)l * 8 * 16384, args.in[9] + l * 1024, it, tid);
        }
        SEAM(pb + 1);
        if (KON(3) && IN(pb + 2)) {
            pg8::Gemm g{ATT, WA, SGU, WB, pg8::MROWS, 2048, 1024}; pg8::StaticOrder S; S.init(pg8::MROWS, 2048, G, blk, 1);
            pg8::EpiMerge E{PROJ, MRG};
            pg8::gemm_phase<pg8::EpiMerge, pg8::StaticOrder, true, true>(lds, g, S, E);
        }
        SEAM(pb + 2);
        if (KON(4) && IN(pb + 3)) {
            pg8::Gemm g{MRG, WO, MRG, WO, pg8::MROWS, 2048, 2048}; pg8::StaticOrder S; S.init(pg8::MROWS, 2048, G, blk, 0);
            pg8::EpiRes E{args.out, XB, SSQ + (size_t)(2 * l + 1) * 8 * pg8::MROWS, 1, RED};
            pg8::gemm_phase<pg8::EpiRes, pg8::StaticOrder, true, true>(lds, g, S, E);
        }
        SEAM(pb + 3);
        if (KON(5) && IN(pb + 4)) {
            pg8::Gemm g{XB, WGU, XB, WGU, pg8::MROWS, 2 * pg8::D_FF, 2048}; pg8::StaticOrder S; S.init(pg8::MROWS, 2 * pg8::D_FF, G, blk, 0);
            pg8::Unit u0; const int pm0 = S.next(0, u0) ? u0.pm : -1; if (pm0 >= 0) build_row_scale(RS, SSQ + (size_t)(2 * l + 1) * 8 * pg8::MROWS, pm0, tid);
            pg8::EpiSwiglu E{ACT, SSQ + (size_t)(2 * l + 1) * 8 * pg8::MROWS, RS, pm0};
            pg8::gemm_phase<pg8::EpiSwiglu, pg8::StaticOrder, true, true>(lds, g, S, E);
            { int thr = S.nwg - ((S.nwg + G - 1) / G - 1) * G; if (thr >= G) thr = 0;
                if (blk >= thr) p0_prologue(args, (blk - thr) * NWAVES + wave, (G - thr) * NWAVES, lane, l == 0 ? 0x07C0u : 0x2000u, false); }
        }
        SEAM(pb + 4);
        if (KON(6) && IN(pb + 5)) {
            pg8::Gemm g{ACT, WD, ACT, WD, pg8::MROWS, 2048, pg8::D_FF}; pg8::StaticOrder S; S.init(pg8::MROWS, 2048, G, blk, 0);
            pg8::EpiRes E{args.out, XB, SSQ + (size_t)((2 * l + 2) & 3) * 8 * pg8::MROWS, l + 1 < DEPTH ? 1 : 0, RED};
            pg8::gemm_phase<pg8::EpiRes, pg8::StaticOrder, true, true>(lds, g, S, E);
        }
        SEAM(pb + 5);
    }
#undef IN
#undef SEAM
}

extern "C" void kernel_launch(void* const* d_in, const int* in_sizes, int n_in, void* d_out, int out_size, void* d_ws, size_t ws_size, hipStream_t stream) {
    static int grid = 0;
    if (grid == 0) {
        if (n_in != 17 || in_sizes[0] != pg8::MROWS * 2048 || out_size != pg8::MROWS * 2048 || ws_size < WS_END) { fprintf(stderr, "kernel_launch: unexpected shapes / workspace (n_in %d, ws %zu)\n", n_in, ws_size); grid = -1; return; }
        int dev = 0, cus = 0, per_cu = 0;
        if (hipGetDevice(&dev) != hipSuccess || hipDeviceGetAttribute(&cus, hipDeviceAttributeMultiprocessorCount, dev) != hipSuccess) { grid = -1; return; }
        if (hipFuncSetAttribute((const void*)mk_fwd, hipFuncAttributeMaxDynamicSharedMemorySize, LDS_BYTES) != hipSuccess) { fprintf(stderr, "kernel_launch: hipFuncSetAttribute failed\n"); grid = -1; return; }
        if (hipOccupancyMaxActiveBlocksPerMultiprocessor(&per_cu, (const void*)mk_fwd, NTHREADS, LDS_BYTES) != hipSuccess || per_cu < 1) { fprintf(stderr, "kernel_launch: occupancy query says %d\n", per_cu); per_cu = 1; }
        (void)hipGetLastError();
        grid = cus * per_cu;
    }
    if (grid < 0) return;
    if (hipMemsetAsync((unsigned char*)d_ws + WS_BAR, 0, BAR_BYTES, stream) != hipSuccess) { fprintf(stderr, "kernel_launch: memset of the barrier words failed\n"); return; }
    Args a{};
    for (int i = 0; i < 17; ++i) a.in[i] = (const float*)d_in[i];
    a.out = (float*)d_out; a.ws = (unsigned char*)d_ws;
#if MK_ONE_LAUNCH
    a.ph_lo = 0; a.ph_hi = NPHASES;
    void* kargs[] = {&a};
    const hipError_t e = hipLaunchCooperativeKernel((const void*)mk_fwd, dim3(grid), dim3(NTHREADS), kargs, LDS_BYTES, stream);
    if (e != hipSuccess) fprintf(stderr, "kernel_launch: cooperative launch failed: %s (grid %d)\n", hipGetErrorString(e), grid);
#else
    for (int p = 0; p < NPHASES; ++p) { a.ph_lo = p; a.ph_hi = p + 1; hipLaunchKernelGGL(mk_fwd, dim3(grid), dim3(NTHREADS), LDS_BYTES, stream, a); }
#endif
}
```

```cpp
#include <hip/hip_runtime.h>
#include <hip/hip_cooperative_groups.h>
#include <cstdio>
#include <cstdint>
namespace cg = cooperative_groups;

#ifndef MK_ONE_LAUNCH
#define MK_ONE_LAUNCH 1
#endif

namespace pg8 {
#define PG8_LAS __attribute__((address_space(3)))
typedef unsigned short bf16_t;
typedef short bf16x8 __attribute__((ext_vector_type(8)));
typedef float f32x4 __attribute__((ext_vector_type(4)));
typedef unsigned u32x4 __attribute__((ext_vector_type(4)));
typedef unsigned u32x2 __attribute__((ext_vector_type(2)));
constexpr int BM = 256, BK = 64, HALF = 128, HTB = HALF * BK * 2  , STAGE_BYTES = 8 * HTB, NXCD = 8, WGM = 4;

__host__ __device__ __forceinline__ int lds_byte(int r, int c) { const int st = (r >> 4) * 2 + (c >> 5), rr = r & 15, cc = c & 31, ob = rr * 64 + cc * 2; return st * 1024 + (ob ^ (((ob >> 9) & 1) << 5)); }
__host__ __device__ __forceinline__ void stage_rc(int b, int& R, int& C) { const int st = b / 1024, sb = b % 1024, swz = sb ^ (((sb >> 9) & 1) << 5); R = (st >> 1) * 16 + swz / 64; C = (st & 1) * 32 + (swz % 64) / 2; }
__host__ __device__ __forceinline__ int perm32(int rho) { const int n = rho >> 4, i = rho & 15; return 8 * (i >> 2) + 4 * n + (i & 3); }

struct Unit { int pm, pn, part; };
struct Gemm { const bf16_t* A; const bf16_t* Bt; const bf16_t* A1; const bf16_t* Bt1; int M, N, K; };

struct StaticOrder {
    int nM, nN, nwg, G, c, dual;
    __host__ __device__ void init(int M, int N, int G_, int c_, int dual_) { nM = M / BM; nN = N / BM; nwg = nM * nN; G = G_; c = c_; dual = dual_; }
    __host__ __device__ bool next(int i, Unit& u) const {
        const int ii = dual ? (i >> 1) : i; u.part = dual ? (i & 1) : 0;
        const long L = (long)ii * G + c; if (L >= nwg) return false;
        int wgid = (int)L; { const int q = nwg / NXCD, r = nwg % NXCD, xcd = wgid % NXCD, off = wgid / NXCD; wgid = (xcd < r ? xcd * (q + 1) : r * (q + 1) + (xcd - r) * q) + off; }
        const int nig = WGM * nN, gid = wgid / nig, fm = gid * WGM, gsz = (nM - fm) < WGM ? (nM - fm) : WGM;
        u.pm = fm + ((wgid % nig) % gsz); u.pn = (wgid % nig) / gsz; return true;
    }
    __device__ __forceinline__ void a_ready(const Unit&) const {}
    __device__ __forceinline__ void done(const Unit&) const {}
};

__device__ __forceinline__ unsigned cvt_pk_bf16(float lo, float hi) { unsigned r; asm volatile("v_cvt_pk_bf16_f32 %0, %1, %2" : "=v"(r) : "v"(lo), "v"(hi)); return r; }
__device__ __forceinline__ void st16_wt(void* p, u32x4 v) { asm volatile("global_store_dwordx4 %0, %1, off sc1\n\ts_nop 1" :: "v"(p), "v"(v) : "memory"); }
__device__ __forceinline__ float bf_lo(unsigned w) { return __uint_as_float(w << 16); }
__device__ __forceinline__ float bf_hi(unsigned w) { return __uint_as_float(w & 0xffff0000u); }
__device__ __forceinline__ float sigmoid_f(float v) { return __builtin_amdgcn_rcpf(1.0f + __expf(-v)); }
__device__ __forceinline__ float gelu_f(float x) { const float y2 = 1.5957691216057308f * x * (1.0f + 0.044715f * x * x); return x * sigmoid_f(y2); }

constexpr int D_MODEL = 2048, IN_W = 7680, D_FF = 5632, MROWS = 8192, SEQ = 2048;
constexpr int C_K = 1024, C_V = 1280, C_U = 1536, C_VS = 2560, C_GA = 3584, C_GB = 5632;
constexpr float EPS = 1e-6f;

struct EpiProj {
    static constexpr bool PERM = true, AFTER_DRAIN = false, CHAIN = false;
    bf16_t* O; const float* ssq; const PG8_LAS float* rs; int pm0;
    __device__ __forceinline__ void operator()(const f32x4 (&acc)[2][2][4][2], const Unit& u, int wr, int wc, int fr, int fq) const {
        const int row0 = u.pm * BM + wr * 64 + fr, col0 = u.pn * BM + wc * 32 + 8 * fq; const bool sig = u.pn >= 14;
        float rr[2][4];
        if (u.pm == pm0) {
#pragma unroll
            for (int ai = 0; ai < 2; ++ai)
#pragma unroll
                for (int m = 0; m < 4; ++m) rr[ai][m] = rs[ai * HALF + wr * 64 + m * 16 + fr];
        } else {
#pragma unroll
            for (int ai = 0; ai < 2; ++ai)
#pragma unroll
                for (int m = 0; m < 4; ++m) { const float* p = ssq + (size_t)(2 * fq) * MROWS + row0 + ai * HALF + m * 16; rr[ai][m] = p[0] + p[MROWS]; }
#pragma unroll
            for (int ai = 0; ai < 2; ++ai)
#pragma unroll
                for (int m = 0; m < 4; ++m) { float t = rr[ai][m]; t += __shfl_xor(t, 16); t += __shfl_xor(t, 32); rr[ai][m] = rsqrtf(t * (1.0f / D_MODEL) + EPS); }
        }
#pragma unroll
        for (int ai = 0; ai < 2; ++ai)
#pragma unroll
            for (int m = 0; m < 4; ++m) { const int row = row0 + ai * HALF + m * 16; const float r = rr[ai][m]; bf16_t* rowp = O + (size_t)row * IN_W + col0;
                if (sig) {
                    const float c1 = r * -1.4426950408889634f; f32x4 ra[2], gb[2];
#pragma unroll
                    for (int n = 0; n < 2; ++n)
#pragma unroll
                        for (int j = 0; j < 4; ++j) { const float da = 1.0f + __builtin_amdgcn_exp2f(acc[ai][0][m][n][j] * c1), db = fminf(1.0f + __builtin_amdgcn_exp2f(acc[ai][1][m][n][j] * c1), 1e30f);
                            ra[n][j] = db * __builtin_amdgcn_rcpf(da); gb[n][j] = __builtin_amdgcn_rcpf(db); }
                    u32x4 w; w.x = cvt_pk_bf16(ra[0][0], ra[0][1]); w.y = cvt_pk_bf16(ra[0][2], ra[0][3]); w.z = cvt_pk_bf16(ra[1][0], ra[1][1]); w.w = cvt_pk_bf16(ra[1][2], ra[1][3]);
                    *(u32x4*)rowp = w;
                    w.x = cvt_pk_bf16(gb[0][0], gb[0][1]); w.y = cvt_pk_bf16(gb[0][2], gb[0][3]); w.z = cvt_pk_bf16(gb[1][0], gb[1][1]); w.w = cvt_pk_bf16(gb[1][2], gb[1][3]);
                    *(u32x4*)(rowp + HALF) = w;
                } else {
#pragma unroll
                for (int bj = 0; bj < 2; ++bj) { const f32x4 v0 = acc[ai][bj][m][0] * r, v1 = acc[ai][bj][m][1] * r;
                    u32x4 w; w.x = cvt_pk_bf16(v0[0], v0[1]); w.y = cvt_pk_bf16(v0[2], v0[3]); w.z = cvt_pk_bf16(v1[0], v1[1]); w.w = cvt_pk_bf16(v1[2], v1[3]);
                    *(u32x4*)(rowp + bj * HALF) = w; } } }
    }
};
struct EpiMerge {
    static constexpr bool PERM = true, AFTER_DRAIN = false, CHAIN = true;
    const bf16_t* P; bf16_t* O;
    __device__ __forceinline__ void operator()(f32x4 (&acc)[2][2][4][2], const Unit& u, int wr, int wc, int fr, int fq) const {
        const int row0 = u.pm * BM + wr * 64 + fr, col0 = u.pn * BM + wc * 32 + 8 * fq;
        const int gcol = C_GA + u.pn * 512 + (u.part ? HALF : 0) + wc * 32 + 8 * fq;
#pragma unroll
        for (int ai = 0; ai < 2; ++ai) {
            u32x4 gw[4][2];
#pragma unroll
            for (int m = 0; m < 4; ++m)
#pragma unroll
                for (int bj = 0; bj < 2; ++bj) gw[m][bj] = *(const u32x4*)(P + (size_t)(row0 + ai * HALF + m * 16) * IN_W + gcol + bj * 256);
#pragma unroll
            for (int m = 0; m < 4; ++m)
#pragma unroll
                for (int bj = 0; bj < 2; ++bj) { const int row = row0 + ai * HALF + m * 16, col = col0 + bj * HALF; const u32x4 g = gw[m][bj];
                    f32x4 g0, g1; g0[0] = bf_lo(g.x); g0[1] = bf_hi(g.x); g0[2] = bf_lo(g.y); g0[3] = bf_hi(g.y); g1[0] = bf_lo(g.z); g1[1] = bf_hi(g.z); g1[2] = bf_lo(g.w); g1[3] = bf_hi(g.w);
                    if (u.part == 0) { acc[ai][bj][m][0] = acc[ai][bj][m][0] * g0; acc[ai][bj][m][1] = acc[ai][bj][m][1] * g1; }
                    else { const f32x4 v0 = acc[ai][bj][m][0] * g0, v1 = acc[ai][bj][m][1] * g1;
                        u32x4 w; w.x = cvt_pk_bf16(v0[0], v0[1]); w.y = cvt_pk_bf16(v0[2], v0[3]); w.z = cvt_pk_bf16(v1[0], v1[1]); w.w = cvt_pk_bf16(v1[2], v1[3]);
                        *(u32x4*)(O + (size_t)row * D_MODEL + col) = w; } } }
    }
};
struct EpiRes {
    static constexpr bool PERM = true, AFTER_DRAIN = false, CHAIN = false;
    float* Xout; bf16_t* XB; float* ssq_out; int aux; PG8_LAS float* red;
    __device__ __forceinline__ void operator()(const f32x4 (&acc)[2][2][4][2], const Unit& u, int wr, int wc, int fr, int fq) const {
        const int row0 = u.pm * BM + wr * 64 + fr, col0 = u.pn * BM + wc * 32 + 8 * fq;
#pragma unroll
        for (int ai = 0; ai < 2; ++ai) {
            u32x4 xw[4][2];
#pragma unroll
            for (int m = 0; m < 4; ++m)
#pragma unroll
                for (int bj = 0; bj < 2; ++bj) xw[m][bj] = *(const u32x4*)(XB + (size_t)(row0 + ai * HALF + m * 16) * D_MODEL + col0 + bj * HALF);
#pragma unroll
            for (int m = 0; m < 4; ++m) { const int row = row0 + ai * HALF + m * 16; float ss = 0.f;
#pragma unroll
                for (int bj = 0; bj < 2; ++bj) { const size_t o = (size_t)row * D_MODEL + col0 + bj * HALF; const u32x4 t = xw[m][bj];
                    f32x4 v0, v1; v0[0] = bf_lo(t.x); v0[1] = bf_hi(t.x); v0[2] = bf_lo(t.y); v0[3] = bf_hi(t.y); v1[0] = bf_lo(t.z); v1[1] = bf_hi(t.z); v1[2] = bf_lo(t.w); v1[3] = bf_hi(t.w);
                    v0 = v0 + acc[ai][bj][m][0]; v1 = v1 + acc[ai][bj][m][1];
                    if (aux) { u32x4 w; w.x = cvt_pk_bf16(v0[0], v0[1]); w.y = cvt_pk_bf16(v0[2], v0[3]); w.z = cvt_pk_bf16(v1[0], v1[1]); w.w = cvt_pk_bf16(v1[2], v1[3]);
                        *(u32x4*)(XB + o) = w;
                        ss += (v0[0] * v0[0] + v0[1] * v0[1]) + (v0[2] * v0[2] + v0[3] * v0[3]) + (v1[0] * v1[0] + v1[1] * v1[1]) + (v1[2] * v1[2] + v1[3] * v1[3]); }
                    else { *(f32x4*)(Xout + o) = v0; *(f32x4*)(Xout + o + 4) = v1; } }
                if (aux) { ss += __shfl_xor(ss, 16); ss += __shfl_xor(ss, 32); if (fq == 0) red[(ai * HALF + wr * 64 + m * 16 + fr) * 4 + wc] = ss; } } }
        if (aux) {
            asm volatile("s_waitcnt lgkmcnt(0)" ::: "memory"); __builtin_amdgcn_s_barrier(); asm volatile("" ::: "memory");
            const int t = (wr * 4 + wc) * 64 + fq * 16 + fr;
            if (t < BM) { const f32x4 p = *(const PG8_LAS f32x4*)(red + 4 * t); ssq_out[(size_t)u.pn * MROWS + u.pm * BM + t] = (p[0] + p[1]) + (p[2] + p[3]); }
        }
    }
};
struct EpiSwiglu {
    static constexpr bool PERM = true, AFTER_DRAIN = false, CHAIN = false;
    bf16_t* O; const float* ssq; const PG8_LAS float* rs; int pm0;
    __device__ __forceinline__ void operator()(const f32x4 (&acc)[2][2][4][2], const Unit& u, int wr, int wc, int fr, int fq) const {
        const int row0 = u.pm * BM + wr * 64 + fr, col0 = u.pn * HALF + wc * 32 + 8 * fq;
        float rr[2][4];
        if (u.pm == pm0) {
#pragma unroll
            for (int ai = 0; ai < 2; ++ai)
#pragma unroll
                for (int m = 0; m < 4; ++m) rr[ai][m] = rs[ai * HALF + wr * 64 + m * 16 + fr];
        } else {
#pragma unroll
            for (int ai = 0; ai < 2; ++ai)
#pragma unroll
                for (int m = 0; m < 4; ++m) { const float* p = ssq + (size_t)(2 * fq) * MROWS + row0 + ai * HALF + m * 16; rr[ai][m] = p[0] + p[MROWS]; }
#pragma unroll
            for (int ai = 0; ai < 2; ++ai)
#pragma unroll
                for (int m = 0; m < 4; ++m) { float t = rr[ai][m]; t += __shfl_xor(t, 16); t += __shfl_xor(t, 32); rr[ai][m] = rsqrtf(t * (1.0f / D_MODEL) + EPS); }
        }
#pragma unroll
        for (int ai = 0; ai < 2; ++ai)
#pragma unroll
            for (int m = 0; m < 4; ++m) { const int row = row0 + ai * HALF + m * 16; const float r = rr[ai][m];
                float o[8];
#pragma unroll
                for (int n = 0; n < 2; ++n)
#pragma unroll
                    for (int j = 0; j < 4; ++j) { const float g = acc[ai][0][m][n][j] * r, up = acc[ai][1][m][n][j] * r; o[4 * n + j] = g * sigmoid_f(g) * up; }
                u32x4 w; w.x = cvt_pk_bf16(o[0], o[1]); w.y = cvt_pk_bf16(o[2], o[3]); w.z = cvt_pk_bf16(o[4], o[5]); w.w = cvt_pk_bf16(o[6], o[7]);
                *(u32x4*)(O + (size_t)row * D_FF + col0) = w; }
    }
};

template <class Epi, class Sched, bool ALIGN_EPI = false, bool SP2 = false>
__device__ __forceinline__ void gemm_phase(PG8_LAS unsigned char* lds, const Gemm g, const Sched& S, const Epi& E) {
    int tid_ = threadIdx.x; asm volatile("" : "+v"(tid_));
    const int tid = tid_, wid = __builtin_amdgcn_readfirstlane(tid >> 6), lane = tid & 63, wr = wid >> 2, wc = wid & 3, fr = lane & 15, fq = lane >> 4;
    const int K = g.K, nt = K / BK;
    unsigned voffA[2], voffB[2];
#pragma unroll
    for (int i = 0; i < 2; ++i) { int R, C; stage_rc(tid * 16 + i * 8192, R, C); const int Rb = Epi::PERM ? ((R & ~31) + perm32(R & 31)) : R;
        voffA[i] = (unsigned)(R * K + C) * 2u; voffB[i] = (unsigned)(Rb * K + C) * 2u; }
    const size_t kstep = (size_t)(BK * 2);
    const size_t hstep = (size_t)HALF * K * 2;
    const size_t tstep = 2 * hstep;
    const unsigned ldsw = (unsigned)wid * 1024u;
    const int aoff = lds_byte(wr * 64 + fr, fq * 8), boff = lds_byte(wc * 32 + fr, fq * 8);
#define PG8_SA(b, h) (((b) * 2 + (h)) * HTB)
#define PG8_SB(b, h) ((4 + (b) * 2 + (h)) * HTB)
#define PG8_STAGE(bufoff, gbase, voff) do { _Pragma("unroll") for (int _i = 0; _i < 2; ++_i) \
        __builtin_amdgcn_global_load_lds((const unsigned*)((const char*)(gbase) + (voff)[_i]), (PG8_LAS unsigned*)(lds + (bufoff) + ldsw + _i * 8192), 16, 0, 0); } while (0)
#define PG8_LDA(dst, b, h) do { _Pragma("unroll") for (int m = 0; m < 4; ++m) _Pragma("unroll") for (int k = 0; k < 2; ++k) dst[m][k] = *(const PG8_LAS bf16x8*)(lds + PG8_SA(b, h) + aoff + m * 2048 + k * 1024); } while (0)
#define PG8_LDB(dst, b, h) do { _Pragma("unroll") for (int n = 0; n < 2; ++n) _Pragma("unroll") for (int k = 0; k < 2; ++k) dst[n][k] = *(const PG8_LAS bf16x8*)(lds + PG8_SB(b, h) + boff + n * 2048 + k * 1024); } while (0)
#define PG8_MMA(ai, bj, At, Bt) do { __builtin_amdgcn_s_setprio(1); _Pragma("unroll") for (int m = 0; m < 4; ++m) _Pragma("unroll") for (int n = 0; n < 2; ++n) _Pragma("unroll") for (int k = 0; k < 2; ++k) \
        acc[ai][bj][m][n] = __builtin_amdgcn_mfma_f32_16x16x32_bf16(Bt[n][k], At[m][k], acc[ai][bj][m][n], 0, 0, 0); __builtin_amdgcn_s_setprio(0); } while (0)
#define PG8_WAIT_V(n) asm volatile("s_waitcnt vmcnt(" #n ")" ::: "memory")
#define PG8_WAIT_L(n) asm volatile("s_waitcnt lgkmcnt(" #n ")" ::: "memory")
#define PG8_BAR __builtin_amdgcn_s_barrier()
#define PG8_SCHED __builtin_amdgcn_sched_barrier(0)
    Unit cur, nxt; int ui = 0;
    if (!S.next(0, cur)) return;
    f32x4 acc[2][2][4][2];
#pragma unroll
    for (int a = 0; a < 2; ++a)
#pragma unroll
        for (int b = 0; b < 2; ++b)
#pragma unroll
            for (int m = 0; m < 4; ++m)
#pragma unroll
                for (int n = 0; n < 2; ++n) acc[a][b][m][n] = (f32x4){0.f, 0.f, 0.f, 0.f};
    bf16x8 At[4][2], B0[2][2], B1[2][2];
    const char* cA = (const char*)(cur.part ? g.A1 : g.A) + (size_t)cur.pm * tstep; const char* cB = (const char*)(cur.part ? g.Bt1 : g.Bt) + (size_t)cur.pn * tstep;
    S.a_ready(cur);
    if constexpr (SP2) {
        PG8_STAGE(PG8_SB(0, 0), cB, voffB); PG8_STAGE(PG8_SB(0, 1), cB + hstep, voffB); PG8_STAGE(PG8_SA(0, 0), cA, voffA); PG8_STAGE(PG8_SA(0, 1), cA + hstep, voffA);
        if (wr == 1) PG8_BAR;
        PG8_WAIT_V(2); PG8_BAR;
        PG8_STAGE(PG8_SB(1, 0), cB + kstep, voffB); PG8_STAGE(PG8_SA(1, 0), cA + kstep, voffA); PG8_STAGE(PG8_SB(1, 1), cB + hstep + kstep, voffB);
        PG8_WAIT_V(6); PG8_BAR;
    } else {
        PG8_STAGE(PG8_SB(0, 0), cB, voffB); PG8_STAGE(PG8_SA(0, 0), cA, voffA); PG8_STAGE(PG8_SB(0, 1), cB + hstep, voffB); PG8_STAGE(PG8_SA(0, 1), cA + hstep, voffA);
        if (wr == 1) PG8_BAR;
        PG8_WAIT_V(4); PG8_BAR;
        PG8_STAGE(PG8_SB(1, 0), cB + kstep, voffB); PG8_STAGE(PG8_SA(1, 0), cA + kstep, voffA); PG8_STAGE(PG8_SB(1, 1), cB + hstep + kstep, voffB);
        PG8_WAIT_V(6); PG8_BAR;
    }
    for (;;) {
        const bool has_next = S.next(ui + 1, nxt);
        const char* nA = has_next ? (const char*)(nxt.part ? g.A1 : g.A) + (size_t)nxt.pm * tstep : cA; const char* nB = has_next ? (const char*)(nxt.part ? g.Bt1 : g.Bt) + (size_t)nxt.pn * tstep : cB;
        for (int t = 0; t < nt; t += 2) {
            const bool last = (t == nt - 2);
            const char* a1 = cA + (size_t)(t + 1) * kstep;
            const char* a2 = last ? nA : cA + (size_t)(t + 2) * kstep; const char* b2 = last ? nB : cB + (size_t)(t + 2) * kstep;
            const char* a3 = a2 + kstep; const char* b3 = b2 + kstep;
            if (last && has_next) S.a_ready(nxt);
            if constexpr (SP2) {
            PG8_LDB(B0, 0, 0); PG8_LDB(B1, 0, 1); PG8_SCHED; PG8_LDA(At, 0, 0); PG8_STAGE(PG8_SA(1, 1), a1 + hstep, voffA);
            PG8_WAIT_V(8); PG8_WAIT_L(0); PG8_BAR; PG8_MMA(0, 0, At, B0); PG8_MMA(0, 1, At, B1); PG8_BAR; PG8_SCHED;
            PG8_LDA(At, 0, 1); PG8_STAGE(PG8_SB(0, 0), b2, voffB); PG8_STAGE(PG8_SB(0, 1), b2 + hstep, voffB); PG8_STAGE(PG8_SA(0, 0), a2, voffA);
            PG8_WAIT_V(8); PG8_WAIT_L(0); PG8_BAR; PG8_MMA(1, 0, At, B0); PG8_MMA(1, 1, At, B1); PG8_BAR; PG8_SCHED;
            PG8_LDB(B0, 1, 0); PG8_LDB(B1, 1, 1); PG8_SCHED; PG8_LDA(At, 1, 0); PG8_STAGE(PG8_SA(0, 1), a2 + hstep, voffA);
            PG8_WAIT_V(8); PG8_WAIT_L(0); PG8_BAR; PG8_MMA(0, 0, At, B0); PG8_MMA(0, 1, At, B1); PG8_BAR; PG8_SCHED;
            PG8_LDA(At, 1, 1); PG8_STAGE(PG8_SB(1, 0), b3, voffB); PG8_STAGE(PG8_SB(1, 1), b3 + hstep, voffB); PG8_STAGE(PG8_SA(1, 0), a3, voffA);
            PG8_WAIT_V(8); PG8_WAIT_L(0); PG8_BAR; PG8_MMA(1, 0, At, B0); PG8_MMA(1, 1, At, B1); PG8_BAR; PG8_SCHED;
            } else {
            PG8_LDB(B0, 0, 0); PG8_SCHED; PG8_LDA(At, 0, 0); PG8_STAGE(PG8_SA(1, 1), a1 + hstep, voffA);
            PG8_WAIT_L(8); PG8_BAR; PG8_WAIT_L(0); PG8_MMA(0, 0, At, B0); PG8_BAR; PG8_SCHED;
            PG8_LDB(B1, 0, 1); PG8_STAGE(PG8_SB(0, 0), b2, voffB);
            PG8_BAR; PG8_WAIT_L(0); PG8_MMA(0, 1, At, B1); PG8_BAR;
            PG8_LDA(At, 0, 1); PG8_STAGE(PG8_SA(0, 0), a2, voffA);
            PG8_BAR; PG8_WAIT_L(0); PG8_MMA(1, 0, At, B0); PG8_BAR; PG8_SCHED;
            PG8_STAGE(PG8_SB(0, 1), b2 + hstep, voffB);
            PG8_WAIT_V(6); PG8_BAR; PG8_MMA(1, 1, At, B1); PG8_BAR;
            PG8_LDB(B0, 1, 0); PG8_SCHED; PG8_LDA(At, 1, 0); PG8_STAGE(PG8_SA(0, 1), a2 + hstep, voffA);
            PG8_WAIT_L(8); PG8_BAR; PG8_WAIT_L(0); PG8_MMA(0, 0, At, B0); PG8_BAR; PG8_SCHED;
            PG8_LDB(B1, 1, 1); PG8_STAGE(PG8_SB(1, 0), b3, voffB);
            PG8_BAR; PG8_WAIT_L(0); PG8_MMA(0, 1, At, B1); PG8_BAR;
            PG8_LDA(At, 1, 1); PG8_STAGE(PG8_SA(1, 0), a3, voffA);
            PG8_BAR; PG8_WAIT_L(0); PG8_MMA(1, 0, At, B0); PG8_BAR; PG8_SCHED;
            PG8_STAGE(PG8_SB(1, 1), b3 + hstep, voffB);
            PG8_WAIT_V(6); PG8_BAR; PG8_MMA(1, 1, At, B1); PG8_BAR;
            }
        }
        if constexpr (ALIGN_EPI) { if (wr == 0) PG8_BAR; }
        if constexpr (!Epi::AFTER_DRAIN) { E(acc, cur, wr, wc, fr, fq); S.done(cur); }
        if (!has_next) break;
        if (!(Epi::CHAIN && cur.part == 0)) {
#pragma unroll
        for (int a = 0; a < 2; ++a)
#pragma unroll
            for (int b = 0; b < 2; ++b)
#pragma unroll
                for (int m = 0; m < 4; ++m)
#pragma unroll
                    for (int n = 0; n < 2; ++n) acc[a][b][m][n] = (f32x4){0.f, 0.f, 0.f, 0.f};
        }
        cur = nxt; cA = nA; cB = nB; ++ui;
        if constexpr (ALIGN_EPI) { if (wr == 1) PG8_BAR; }
    }
    PG8_WAIT_V(0);
    if constexpr (!ALIGN_EPI) { if (wr == 0) PG8_BAR; }
    PG8_BAR;
    if constexpr (Epi::AFTER_DRAIN) { E.fused(acc, cur, wr, wc, fr, fq, lds, wid, lane); S.done(cur); }
#undef PG8_SA
#undef PG8_SB
#undef PG8_STAGE
#undef PG8_LDA
#undef PG8_LDB
#undef PG8_MMA
#undef PG8_WAIT_V
#undef PG8_WAIT_L
#undef PG8_BAR
#undef PG8_SCHED
}
}

using pg8::bf16_t; using pg8::bf16x8; using pg8::f32x4; using pg8::u32x4; using pg8::u32x2; using pg8::cvt_pk_bf16; using pg8::bf_lo; using pg8::bf_hi; using pg8::gelu_f;
#define LAS __attribute__((address_space(3)))
typedef short s16x4 __attribute__((ext_vector_type(4)));

constexpr int NTHREADS = 512, NWAVES = 8;
constexpr int LDS_BYTES = 147456;
constexpr int DEPTH = 2;
constexpr int NPHASES = 1 + 6 * DEPTH;
static_assert(DEPTH == 2, "the weight-conversion schedule (masks) is written for two layers");
constexpr size_t MiB = 1u << 20;
constexpr size_t WS_SSQ = 0;
constexpr size_t WS_COS = 256 * 1024, WS_SIN = 512 * 1024;
constexpr size_t WS_BAR = 768 * 1024, BAR_BYTES = 16384;
constexpr int LDS_CTL_OFF = 141312;
constexpr size_t WS_WIN = 2 * MiB, SZ_WIN = 30 * MiB;
constexpr size_t WS_WA = 62 * MiB, SZ_WA = 4 * MiB;
constexpr size_t WS_WB = 70 * MiB, SZ_WB = 4 * MiB;
constexpr size_t WS_WO = 78 * MiB, SZ_WO = 8 * MiB;
constexpr size_t WS_WGU = 94 * MiB, SZ_WGU = 44 * MiB;
constexpr size_t WS_WD = 182 * MiB, SZ_WD = 22 * MiB;
constexpr size_t WS_XB = 226 * MiB;
constexpr size_t WS_PROJ = 258 * MiB;
constexpr size_t WS_ATT = 378 * MiB;
constexpr size_t WS_SGU = 394 * MiB;
constexpr size_t WS_MRG = 410 * MiB;
constexpr size_t WS_TMP = 442 * MiB;
constexpr size_t WS_ACT = WS_PROJ;
constexpr size_t WS_PART = 506 * MiB;
constexpr size_t WS_END = 507 * MiB;

struct Args { const float* in[17]; float* out; unsigned char* ws; int ph_lo, ph_hi; };

__device__ __forceinline__ float wave_sum(float v) {
#pragma unroll
    for (int o = 1; o < 64; o <<= 1) v += __shfl_xor(v, o);
    return v;
}

__device__ __forceinline__ void tr_item(const float* __restrict__ W, int K, int N, bf16_t* WT, const float* __restrict__ kscale, int rowmode, int item, int lane) {
    const int nblk = N >> 5, kb = item / nblk, nb = item - kb * nblk;
    const int c = lane >> 3, q = lane & 7, k0 = kb * 64 + c * 8, n0 = nb * 32 + q * 4;
    f32x4 v[8];
#pragma unroll
    for (int i = 0; i < 8; ++i) v[i] = __builtin_nontemporal_load((const f32x4*)(W + (size_t)(k0 + i) * N + n0));
    if (kscale) { const f32x4 s0 = *(const f32x4*)(kscale + k0), s1 = *(const f32x4*)(kscale + k0 + 4);
#pragma unroll
        for (int i = 0; i < 4; ++i) { v[i] = v[i] * s0[i]; v[4 + i] = v[4 + i] * s1[i]; } }
    int drow;
    if (rowmode == 0) drow = n0;
    else if (rowmode == 3) { const int g = n0 - pg8::C_GA; drow = g < 0 ? n0 : pg8::C_GA + (((g & 2047) >> 7) << 8) + ((g >> 11) << 7) + (g & 127); }
    else drow = ((n0 >> 7) << 8) + (n0 & 127) + (rowmode == 2 ? 128 : 0);
#pragma unroll
    for (int e = 0; e < 4; ++e) { u32x4 o; o.x = cvt_pk_bf16(v[0][e], v[1][e]); o.y = cvt_pk_bf16(v[2][e], v[3][e]); o.z = cvt_pk_bf16(v[4][e], v[5][e]); o.w = cvt_pk_bf16(v[6][e], v[7][e]);
        pg8::st16_wt(WT + (size_t)(drow + e) * K + k0, o); }
}

__device__ __forceinline__ void p0_prologue(const Args& a, int gw, int NGW, int lane, unsigned mask, bool do_x, unsigned fmask = 0u, int flo = 0, int fhi = 16) {
    unsigned char* ws = a.ws;
    int base = 0;
#pragma unroll 1
    for (int mi = 0; mi < 7 * DEPTH; ++mi) {
        if (!((mask >> mi) & 1u)) continue;
        const int l = mi / 7, kind = mi - 7 * l;
        const float* W; const float* ks = nullptr; bf16_t* WT; int K, N, rm = 0;
        if (kind == 0)      { W = a.in[2] + (size_t)l * 2048 * 7680;  K = 2048; N = 7680; WT = (bf16_t*)(ws + WS_WIN + l * SZ_WIN); ks = a.in[1] + l * 2048; rm = 3; }
        else if (kind == 1) { W = a.in[10] + (size_t)l * 1024 * 2048; K = 1024; N = 2048; WT = (bf16_t*)(ws + WS_WA + l * SZ_WA); }
        else if (kind == 2) { W = a.in[11] + (size_t)l * 1024 * 2048; K = 1024; N = 2048; WT = (bf16_t*)(ws + WS_WB + l * SZ_WB); }
        else if (kind == 3) { W = a.in[12] + (size_t)l * 2048 * 2048; K = 2048; N = 2048; WT = (bf16_t*)(ws + WS_WO + l * SZ_WO); }
        else if (kind == 4) { W = a.in[14] + (size_t)l * 2048 * 5632; K = 2048; N = 5632; WT = (bf16_t*)(ws + WS_WGU + l * SZ_WGU); ks = a.in[13] + l * 2048; rm = 1; }
        else if (kind == 5) { W = a.in[15] + (size_t)l * 2048 * 5632; K = 2048; N = 5632; WT = (bf16_t*)(ws + WS_WGU + l * SZ_WGU); ks = a.in[13] + l * 2048; rm = 2; }
        else                { W = a.in[16] + (size_t)l * 5632 * 2048; K = 5632; N = 2048; WT = (bf16_t*)(ws + WS_WD + l * SZ_WD); }
        const int nitems = (K >> 6) * (N >> 5);
        int ilo = 0, ihi = nitems; if ((fmask >> mi) & 1u) { ilo = (nitems * flo) >> 4; ihi = (nitems * fhi) >> 4; }
        const int cnt = ihi - ilo;
        int first = (gw - base) % NGW; if (first < 0) first += NGW;
        for (int it = first; it < cnt; it += NGW) tr_item(W, K, N, WT, ks, rm, ilo + it, lane);
        base = (base + cnt) % NGW;
    }
    if (!do_x) return;
    const float* x = a.in[0]; bf16_t* XB = (bf16_t*)(ws + WS_XB); float* SSQ = (float*)(ws + WS_PART);
    for (int row = gw; row < pg8::MROWS; row += NGW) {
        const f32x4* xr = (const f32x4*)(x + (size_t)row * 2048) + lane; u32x2* xo = (u32x2*)(XB + (size_t)row * 2048) + lane; float ss = 0.f;
#pragma unroll
        for (int j = 0; j < 8; ++j) { const f32x4 v = xr[64 * j]; ss += (v[0] * v[0] + v[1] * v[1]) + (v[2] * v[2] + v[3] * v[3]); u32x2 o; o.x = cvt_pk_bf16(v[0], v[1]); o.y = cvt_pk_bf16(v[2], v[3]); xo[64 * j] = o; }
        ss = wave_sum(ss); if (lane < 8) SSQ[(size_t)lane * pg8::MROWS + row] = lane == 0 ? ss : 0.f;
    }
    const int gt = gw * 64 + lane, NGT = NGW * 64;
    float* COS = (float*)(ws + WS_COS); float* SIN = (float*)(ws + WS_SIN);
    for (int i = gt; i < pg8::SEQ * 32; i += NGT) {
        const int pos = i >> 5, f = i & 31;
        float invf = 1.0f; { float m8 = 1.0f;
            const int hi = f >> 3, lo = f & 7; const double c1 = 0.7498942093324559; double p = 1.0; for (int t = 0; t < lo; ++t) p *= c1; double d = 1.0; for (int t = 0; t < hi; ++t) d *= 0.1; invf = (float)(p * d); (void)m8; }
        const float angf = (float)pos * invf;
        const double ang = (double)angf;
        const double qd = __builtin_rint(ang * 0.6366197723675814); const int qi = (int)qd;
        const double r = (ang - qd * 1.5707963267948966) - qd * 6.123233995736766e-17, r2 = r * r;
        double sp = r * (1.0 + r2 * (-1.0 / 6 + r2 * (1.0 / 120 + r2 * (-1.0 / 5040 + r2 * (1.0 / 362880 + r2 * (-1.0 / 39916800 + r2 * (1.0 / 6227020800.0 + r2 * (-1.0 / 1307674368000.0))))))));
        double cp = 1.0 + r2 * (-0.5 + r2 * (1.0 / 24 + r2 * (-1.0 / 720 + r2 * (1.0 / 40320 + r2 * (-1.0 / 3628800 + r2 * (1.0 / 479001600 + r2 * (-1.0 / 87178291200.0 + r2 * (1.0 / 20922789888000.0))))))));
        double s, c; switch (qi & 3) { case 0: s = sp; c = cp; break; case 1: s = cp; c = -sp; break; case 2: s = -sp; c = -cp; break; default: s = -cp; c = sp; break; }
        COS[i] = (float)c; SIN[i] = (float)s;
    }
}

constexpr int KS_STRIDE = 144, VT_STRIDE = 528, KS_BYTES = 256 * KS_STRIDE, VT_BYTES = 64 * VT_STRIDE, VN_STRIDE = 272, VN_OFF0 = 71680, VN_BYTES = 128 * VN_STRIDE, VN_OFF1 = VN_OFF0 + VN_BYTES;
static_assert(KS_BYTES + VT_BYTES <= VN_OFF0 && VN_OFF1 + VN_BYTES <= LDS_CTL_OFF, "P2 LDS map");
#define MFMA16(a, b, c) __builtin_amdgcn_mfma_f32_16x16x32_bf16((a), (b), (c), 0, 0, 0)
__device__ __forceinline__ void unpack8(const u32x4 w, float* f) { f[0] = bf_lo(w.x); f[1] = bf_hi(w.x); f[2] = bf_lo(w.y); f[3] = bf_hi(w.y); f[4] = bf_lo(w.z); f[5] = bf_hi(w.z); f[6] = bf_lo(w.w); f[7] = bf_hi(w.w); }

__device__ __forceinline__ void p2_block(LAS unsigned char* lds, const bf16_t* __restrict__ PROJ, bf16_t* __restrict__ ATT, bf16_t* __restrict__ SGU, const float* __restrict__ qn, const float* __restrict__ kn,
                                         const float* __restrict__ sinks, const float* __restrict__ COS, const float* __restrict__ SIN, const float* __restrict__ lng, const float* __restrict__ lnb,
                                         const float* __restrict__ wsp, const float* __restrict__ bsp, int item, int tid) {
    asm volatile("" : "+v"(tid));
    const int b = item >> 6, n = (item >> 2) & 15, kvh = item & 3;
    const int lane = tid & 63, w = __builtin_amdgcn_readfirstlane(tid >> 6), fr = lane & 15, fq = lane >> 4;
    LAS unsigned char* KS = lds; LAS unsigned char* VT = lds + KS_BYTES;
    const int g = w >> 1, rbase = (w & 1) * 64, hq = kvh * 4 + g;
    const int kk = tid >> 1, h = tid & 1, s = n * 128 - 128 + kk, sc = s < 0 ? 0 : s;
    const bf16_t* rowp = PROJ + (size_t)(b * pg8::SEQ + sc) * pg8::IN_W;
    const bf16_t* kp = rowp + pg8::C_K + kvh * 64 + 16 * h;
    const u32x4 ka = *(const u32x4*)kp, kb = *(const u32x4*)(kp + 8), kc = *(const u32x4*)(kp + 32), kd = *(const u32x4*)(kp + 40);
    const bf16_t* vp = rowp + pg8::C_V + kvh * 64 + 32 * h;
    u32x4 vv[4];
#pragma unroll
    for (int c4 = 0; c4 < 4; ++c4) vv[c4] = *(const u32x4*)(vp + 8 * c4);
    const int sp_ = tid >> 2, q4 = tid & 3;
    u32x4 sv[2][4];
    const bf16_t* svsrc = PROJ + ((size_t)b * pg8::SEQ + n * 128 + sp_) * pg8::IN_W + pg8::C_VS + (2 * kvh) * 128 + 32 * q4;
#pragma unroll
    for (int c4 = 0; c4 < 4; ++c4) sv[0][c4] = *(const u32x4*)(svsrc + 8 * c4);
    u32x4 qa[4], qb[4];
#pragma unroll
    for (int c = 0; c < 2; ++c) { const bf16_t* qp = PROJ + ((size_t)b * pg8::SEQ + n * 128 + rbase + 16 * c + fr) * pg8::IN_W + hq * 64 + 8 * fq; qa[c] = *(const u32x4*)qp; qb[c] = *(const u32x4*)(qp + 32); }
    {
        const float valid = s < 0 ? 0.f : 1.f;
        float x1[16], x2[16]; unpack8(ka, x1); unpack8(kb, x1 + 8); unpack8(kc, x2); unpack8(kd, x2 + 8);
        float ss = 0.f;
#pragma unroll
        for (int j = 0; j < 16; ++j) ss += x1[j] * x1[j] + x2[j] * x2[j];
        ss += __shfl_xor(ss, 1);
        const float rinv = rsqrtf(ss * (1.0f / 64.0f) + pg8::EPS) * valid;
        const float* cp = COS + sc * 32 + 16 * h; const float* sp = SIN + sc * 32 + 16 * h;
        float o1[16], o2[16];
#pragma unroll
        for (int j = 0; j < 16; ++j) { const float a1 = x1[j] * rinv * kn[16 * h + j], a2 = x2[j] * rinv * kn[32 + 16 * h + j], c = cp[j], sn = sp[j]; o1[j] = a1 * c - a2 * sn; o2[j] = a2 * c + a1 * sn; }
        LAS unsigned char* kdst = KS + kk * KS_STRIDE + 32 * h;
        u32x4 w0, w1;
        w0.x = cvt_pk_bf16(o1[0], o1[1]); w0.y = cvt_pk_bf16(o1[2], o1[3]); w0.z = cvt_pk_bf16(o1[4], o1[5]); w0.w = cvt_pk_bf16(o1[6], o1[7]);
        w1.x = cvt_pk_bf16(o1[8], o1[9]); w1.y = cvt_pk_bf16(o1[10], o1[11]); w1.z = cvt_pk_bf16(o1[12], o1[13]); w1.w = cvt_pk_bf16(o1[14], o1[15]);
        *(LAS u32x4*)kdst = w0; *(LAS u32x4*)(kdst + 16) = w1;
        w0.x = cvt_pk_bf16(o2[0], o2[1]); w0.y = cvt_pk_bf16(o2[2], o2[3]); w0.z = cvt_pk_bf16(o2[4], o2[5]); w0.w = cvt_pk_bf16(o2[6], o2[7]);
        w1.x = cvt_pk_bf16(o2[8], o2[9]); w1.y = cvt_pk_bf16(o2[10], o2[11]); w1.z = cvt_pk_bf16(o2[12], o2[13]); w1.w = cvt_pk_bf16(o2[14], o2[15]);
        *(LAS u32x4*)(kdst + 64) = w0; *(LAS u32x4*)(kdst + 80) = w1;
#pragma unroll
        for (int c4 = 0; c4 < 4; ++c4) { u32x4 t = vv[c4]; if (s < 0) t = (u32x4){0u, 0u, 0u, 0u};
            LAS unsigned char* vd = VT + (32 * h + 8 * c4) * VT_STRIDE + kk * 2;
            *(LAS unsigned short*)(vd + 0 * VT_STRIDE) = (unsigned short)(t.x & 0xffffu); *(LAS unsigned short*)(vd + 1 * VT_STRIDE) = (unsigned short)(t.x >> 16);
            *(LAS unsigned short*)(vd + 2 * VT_STRIDE) = (unsigned short)(t.y & 0xffffu); *(LAS unsigned short*)(vd + 3 * VT_STRIDE) = (unsigned short)(t.y >> 16);
            *(LAS unsigned short*)(vd + 4 * VT_STRIDE) = (unsigned short)(t.z & 0xffffu); *(LAS unsigned short*)(vd + 5 * VT_STRIDE) = (unsigned short)(t.z >> 16);
            *(LAS unsigned short*)(vd + 6 * VT_STRIDE) = (unsigned short)(t.w & 0xffffu); *(LAS unsigned short*)(vd + 7 * VT_STRIDE) = (unsigned short)(t.w >> 16); }
    }
#pragma unroll
    for (int gi = 0; gi < 2; ++gi) {
        const int gg = 2 * kvh + gi;
        if (gi == 0) {
#pragma unroll
            for (int c4 = 0; c4 < 4; ++c4) sv[1][c4] = *(const u32x4*)(svsrc + 128 + 8 * c4); }
        float v[32];
#pragma unroll
        for (int c4 = 0; c4 < 4; ++c4) unpack8(sv[gi][c4], v + 8 * c4);
        float sm = 0.f;
#pragma unroll
        for (int j = 0; j < 32; ++j) { v[j] = gelu_f(v[j]); sm += v[j]; }
        sm += __shfl_xor(sm, 1); sm += __shfl_xor(sm, 2);
        const float mu = sm * (1.0f / 128.0f); float q = 0.f;
#pragma unroll
        for (int j = 0; j < 32; ++j) { v[j] -= mu; q += v[j] * v[j]; }
        q += __shfl_xor(q, 1); q += __shfl_xor(q, 2);
        const float rstd = rsqrtf(q * (1.0f / 128.0f) + pg8::EPS);
        const float* gp = lng + gg * 128 + 32 * q4; const float* bp = lnb + gg * 128 + 32 * q4;
        LAS unsigned char* dst = lds + (gi ? VN_OFF1 : VN_OFF0) + (32 * q4) * VN_STRIDE + sp_ * 2;
#pragma unroll
        for (int j = 0; j < 32; j += 2) { const unsigned pk = cvt_pk_bf16(v[j] * rstd * gp[j] + bp[j], v[j + 1] * rstd * gp[j + 1] + bp[j + 1]);
            *(LAS unsigned short*)(dst + j * VN_STRIDE) = (unsigned short)(pk & 0xffffu); *(LAS unsigned short*)(dst + (j + 1) * VN_STRIDE) = (unsigned short)(pk >> 16); }
    }
    __syncthreads();
#pragma unroll
    for (int c = 2; c < 4; ++c) { const bf16_t* qp = PROJ + ((size_t)b * pg8::SEQ + n * 128 + rbase + 16 * c + fr) * pg8::IN_W + hq * 64 + 8 * fq; qa[c] = *(const u32x4*)qp; qb[c] = *(const u32x4*)(qp + 32); }
    const float sink = sinks[hq];
    constexpr float LOG2E = 1.4426950408889634f;
#pragma unroll
    for (int c = 0; c < 4; ++c) {
        const int i0 = rbase + 16 * c, irow = i0 + fr, pos = n * 128 + irow; const size_t grow = (size_t)b * pg8::SEQ + pos;
        bf16x8 qf0, qf1;
        {
            float x1[8], x2[8]; unpack8(qa[c], x1); unpack8(qb[c], x2);
            float ss = 0.f;
#pragma unroll
            for (int j = 0; j < 8; ++j) ss += x1[j] * x1[j] + x2[j] * x2[j];
            ss += __shfl_xor(ss, 16); ss += __shfl_xor(ss, 32);
            const float rinv = rsqrtf(ss * (1.0f / 64.0f) + pg8::EPS) * 0.125f;
            const float* cp = COS + pos * 32 + 8 * fq; const float* sp = SIN + pos * 32 + 8 * fq;
            float o1[8], o2[8];
#pragma unroll
            for (int j = 0; j < 8; ++j) { const float a1 = x1[j] * rinv * qn[8 * fq + j], a2 = x2[j] * rinv * qn[32 + 8 * fq + j], cc = cp[j], sn = sp[j]; o1[j] = a1 * cc - a2 * sn; o2[j] = a2 * cc + a1 * sn; }
            u32x4 w0, w1;
            w0.x = cvt_pk_bf16(o1[0], o1[1]); w0.y = cvt_pk_bf16(o1[2], o1[3]); w0.z = cvt_pk_bf16(o1[4], o1[5]); w0.w = cvt_pk_bf16(o1[6], o1[7]);
            w1.x = cvt_pk_bf16(o2[0], o2[1]); w1.y = cvt_pk_bf16(o2[2], o2[3]); w1.z = cvt_pk_bf16(o2[4], o2[5]); w1.w = cvt_pk_bf16(o2[6], o2[7]);
            qf0 = __builtin_bit_cast(bf16x8, w0); qf1 = __builtin_bit_cast(bf16x8, w1);
        }
        const int t0 = (i0 >> 4) < 6 ? (i0 >> 4) : 6;
        f32x4 sc_[10];
        const LAS unsigned char* kbase = KS + (16 * t0 + fr) * KS_STRIDE + 16 * fq;
#pragma unroll
        for (int t = 0; t < 10; ++t) { const bf16x8 k0 = *(const LAS bf16x8*)(kbase + t * 16 * KS_STRIDE), k1 = *(const LAS bf16x8*)(kbase + t * 16 * KS_STRIDE + 64);
            f32x4 z = (f32x4){0.f, 0.f, 0.f, 0.f}; z = MFMA16(k0, qf0, z); sc_[t] = MFMA16(k1, qf1, z); }
        float mx = -1e30f;
#pragma unroll
        for (int t = 0; t < 10; ++t)
#pragma unroll
            for (int e = 0; e < 4; ++e) { const int kx = 16 * (t0 + t) + 4 * fq + e, d = kx - irow; const bool ok = (d >= 1) && (d <= 128) && (n > 0 || kx >= 128);
                const float v = ok ? sc_[t][e] : -1e30f; sc_[t][e] = v; mx = fmaxf(mx, v); }
        mx = fmaxf(mx, __shfl_xor(mx, 16)); mx = fmaxf(mx, __shfl_xor(mx, 32)); mx = fmaxf(mx, sink);
        float sum = 0.f;
#pragma unroll
        for (int t = 0; t < 10; ++t)
#pragma unroll
            for (int e = 0; e < 4; ++e) { const float p = __builtin_amdgcn_exp2f((sc_[t][e] - mx) * LOG2E); sc_[t][e] = p; sum += p; }
        sum += __shfl_xor(sum, 16); sum += __shfl_xor(sum, 32);
        const float inv = 1.0f / (sum + __builtin_amdgcn_exp2f((sink - mx) * LOG2E));
        f32x4 o[4];
#pragma unroll
        for (int dt = 0; dt < 4; ++dt) o[dt] = (f32x4){0.f, 0.f, 0.f, 0.f};
#pragma unroll
        for (int j = 0; j < 5; ++j) {
            u32x4 pw; pw.x = cvt_pk_bf16(sc_[2 * j][0], sc_[2 * j][1]); pw.y = cvt_pk_bf16(sc_[2 * j][2], sc_[2 * j][3]); pw.z = cvt_pk_bf16(sc_[2 * j + 1][0], sc_[2 * j + 1][1]); pw.w = cvt_pk_bf16(sc_[2 * j + 1][2], sc_[2 * j + 1][3]);
            const bf16x8 pf = __builtin_bit_cast(bf16x8, pw);
#pragma unroll
            for (int dt = 0; dt < 4; ++dt) { const LAS unsigned char* vb = VT + (16 * dt + fr) * VT_STRIDE + (16 * (t0 + 2 * j) + 4 * fq) * 2;
                const u32x2 va = *(const LAS u32x2*)vb, vc = *(const LAS u32x2*)(vb + 32); u32x4 vw; vw.x = va.x; vw.y = va.y; vw.z = vc.x; vw.w = vc.y;
                o[dt] = MFMA16(__builtin_bit_cast(bf16x8, vw), pf, o[dt]); }
        }
        bf16_t* op = ATT + grow * 1024 + hq * 64 + 4 * fq;
#pragma unroll
        for (int dt = 0; dt < 4; ++dt) { u32x2 ow; ow.x = cvt_pk_bf16(o[dt][0] * inv, o[dt][1] * inv); ow.y = cvt_pk_bf16(o[dt][2] * inv, o[dt][3] * inv); *(u32x2*)(op + 16 * dt) = ow; }
    }
#pragma unroll
    for (int gi = 0; gi < 2; ++gi) {
        const int gg = 2 * kvh + gi, irow = 16 * w + fr, nks = (w >> 1) + 1;
        const LAS unsigned char* VNT = lds + (gi ? VN_OFF1 : VN_OFF0);
        f32x4 acc[8];
#pragma unroll
        for (int dt = 0; dt < 8; ++dt) acc[dt] = (f32x4){0.f, 0.f, 0.f, 0.f};
        const float* wrow = wsp + (size_t)gg * 16384 + irow * 128 + 8 * fq;
#pragma unroll
        for (int ks = 0; ks < 4; ++ks) if (ks < nks) {
            const f32x4 wa = *(const f32x4*)(wrow + 32 * ks), wb = *(const f32x4*)(wrow + 32 * ks + 4);
            const int j0 = 32 * ks + 8 * fq; float wv[8];
#pragma unroll
            for (int e = 0; e < 4; ++e) { wv[e] = (j0 + e <= irow) ? wa[e] : 0.f; wv[4 + e] = (j0 + 4 + e <= irow) ? wb[e] : 0.f; }
            u32x4 ww; ww.x = cvt_pk_bf16(wv[0], wv[1]); ww.y = cvt_pk_bf16(wv[2], wv[3]); ww.z = cvt_pk_bf16(wv[4], wv[5]); ww.w = cvt_pk_bf16(wv[6], wv[7]);
            const bf16x8 wf = __builtin_bit_cast(bf16x8, ww);
#pragma unroll
            for (int dt = 0; dt < 8; ++dt) { const bf16x8 af = *(const LAS bf16x8*)(VNT + (16 * dt + fr) * VN_STRIDE + (32 * ks + 8 * fq) * 2); acc[dt] = MFMA16(af, wf, acc[dt]); }
        }
        const float bias = bsp[gg * 128 + irow];
        const size_t grow = (size_t)b * pg8::SEQ + n * 128 + irow;
        const bf16_t* up = PROJ + grow * pg8::IN_W + pg8::C_U + gg * 128 + 4 * fq; bf16_t* op = SGU + grow * 1024 + gg * 128 + 4 * fq;
#pragma unroll
        for (int dt = 0; dt < 8; ++dt) { const u32x2 uw = *(const u32x2*)(up + 16 * dt);
            const float u0 = gelu_f(bf_lo(uw.x)), u1 = gelu_f(bf_hi(uw.x)), u2 = gelu_f(bf_lo(uw.y)), u3 = gelu_f(bf_hi(uw.y));
            u32x2 ow; ow.x = cvt_pk_bf16(u0 * (acc[dt][0] + bias), u1 * (acc[dt][1] + bias)); ow.y = cvt_pk_bf16(u2 * (acc[dt][2] + bias), u3 * (acc[dt][3] + bias)); *(u32x2*)(op + 16 * dt) = ow; }
    }
    __syncthreads();
}

#define XB_TMO      128
#define XB_XCNT(j)  (256  + 64 * (j))
#define XB_XSUB(j)  (1280 + 64 * (j))
#define XB_XGEN(j)  (2304 + 64 * (j))
#define XB_TOP      3328
#define XB_TOPGEN   3392
#define XCD_BAR_WORDS 3456
#define XB_SPIN_CAP (1u << 18)

__device__ __forceinline__ unsigned xb_ld(unsigned* p)              { return __hip_atomic_load(p, __ATOMIC_RELAXED, __HIP_MEMORY_SCOPE_AGENT); }
__device__ __forceinline__ unsigned xb_add(unsigned* p, unsigned v) { return __hip_atomic_fetch_add(p, v, __ATOMIC_RELAXED, __HIP_MEMORY_SCOPE_AGENT); }
__device__ __forceinline__ unsigned xb_xcc_id() { return (unsigned)__builtin_amdgcn_s_getreg((3 << 11) | 20) & 0xFu; }
#define XB_SPIN(cond, bar) do { unsigned _sp = 0; while (cond) { __builtin_amdgcn_s_sleep(1); \
    if ((++_sp & 255u) == 0u) { if (xb_ld(&(bar)[XB_TMO])) break; if (_sp > XB_SPIN_CAP) { atomicAdd(&(bar)[XB_TMO], 1u); break; } } } } while (0)

struct XcdBarrier {
    unsigned* bar; unsigned x;
    volatile LAS unsigned* st;
};

__device__ __forceinline__ XcdBarrier xcd_barrier_post(unsigned* bar, volatile LAS unsigned* st) {
    XcdBarrier b; b.bar = bar; b.x = xb_xcc_id(); b.st = st;
    if (threadIdx.x == 0) (void)xb_add(&bar[XB_XCNT(b.x)], 1u);
    return b;
}
__device__ __forceinline__ void xcd_barrier_complete(unsigned* bar, unsigned x, unsigned& nloc, unsigned& nx) {
    const unsigned G = gridDim.x * gridDim.y * gridDim.z;
    unsigned sum, cnt, mine, sp = 0u;
    for (;;) {
        sum = 0u; cnt = 0u; mine = 0u;
#pragma unroll
        for (unsigned j = 0; j < 16; ++j) { const unsigned c = xb_ld(&bar[XB_XCNT(j)]); sum += c; cnt += (c > 0u) ? 1u : 0u; mine = (j == x) ? c : mine; }
        if (sum == G) break;
        __builtin_amdgcn_s_sleep(1);
        if ((++sp & 255u) == 0u) { if (xb_ld(&bar[XB_TMO])) break; if (sp > XB_SPIN_CAP) { atomicAdd(&bar[XB_TMO], 1u); break; } }
    }
    nloc = mine > 0u ? mine : 1u; nx = cnt > 0u ? cnt : 1u;
}

__device__ __forceinline__ void xcd_barrier(const XcdBarrier& b) {
    asm volatile("s_waitcnt vmcnt(0)" ::: "memory");
    __syncthreads();
    if (threadIdx.x == 0) {
        unsigned* bar = b.bar;
        __builtin_amdgcn_s_waitcnt(0);
        unsigned nloc = b.st[0], nx = b.st[1];
        if (nloc == 0u) { xcd_barrier_complete(bar, b.x, nloc, nx); b.st[0] = nloc; b.st[1] = nx; }
        const unsigned old = xb_add(&bar[XB_XSUB(b.x)], 1u);
        const unsigned gen = old / nloc;
        if (old + 1u == (gen + 1u) * nloc) {
            __builtin_amdgcn_fence(__ATOMIC_RELEASE, "agent");
            asm volatile("s_waitcnt vmcnt(0)" ::: "memory");
            const unsigned og = xb_add(&bar[XB_TOP], 1u);
            const unsigned tg = og / nx;
            if (og + 1u == (tg + 1u) * nx) xb_add(&bar[XB_TOPGEN], 1u);
            else XB_SPIN(xb_ld(&bar[XB_TOPGEN]) == tg, bar);
            __builtin_amdgcn_fence(__ATOMIC_ACQUIRE, "agent");
            xb_add(&bar[XB_XGEN(b.x)], 1u);
            asm volatile("s_waitcnt vmcnt(0)" ::: "memory");
        } else {
            __builtin_amdgcn_fence(__ATOMIC_ACQUIRE, "agent");
            asm volatile("s_waitcnt vmcnt(0)" ::: "memory");
            XB_SPIN(xb_ld(&bar[XB_XGEN(b.x)]) == gen, bar);
            asm volatile("" ::: "memory");
            asm volatile("s_waitcnt vmcnt(0)" ::: "memory");
        }
    }
    __syncthreads();
}


__device__ __forceinline__ void build_row_scale(LAS float* rs, const float* part, int pm, int tid) {
    if (tid < 256) { float t = 0.f;
#pragma unroll
        for (int j = 0; j < 8; ++j) t += part[(size_t)j * pg8::MROWS + pm * 256 + tid];
        rs[tid] = rsqrtf(t * (1.0f / pg8::D_MODEL) + pg8::EPS); }
    __syncthreads();
}

__global__ void __launch_bounds__(NTHREADS, 2) mk_fwd(Args args) {
    extern __shared__ __attribute__((aligned(16))) unsigned char lds_raw[];
    LAS unsigned char* lds = (LAS unsigned char*)lds_raw;
    const int tid = threadIdx.x, lane = tid & 63, wave = __builtin_amdgcn_readfirstlane(tid >> 6);
    const int G = gridDim.x, blk = blockIdx.x;
    unsigned char* ws = args.ws;
    const int lo = args.ph_lo, hi = args.ph_hi;
#define IN(k) (lo <= (k) && (k) < hi)
#ifndef PH_MASK
#define PH_MASK 127
#endif
#define KON(kind) (((PH_MASK) >> (kind)) & 1)
#define SEAM(k) do { if (IN(k) && IN((k) + 1)) { if (hi > 4096) cg::this_grid().sync(); else xcd_barrier(bar); } } while (0)
    for (int u = tid; u < 64; u += NTHREADS) ((LAS unsigned*)(lds + LDS_CTL_OFF))[u] = 0u;
    __syncthreads();
    const XcdBarrier bar = xcd_barrier_post((unsigned*)(ws + WS_BAR), (volatile LAS unsigned*)(lds + LDS_CTL_OFF + 32));
    float* SSQ = (float*)(ws + WS_PART); PG8_LAS float* RED = (PG8_LAS float*)(lds + LDS_CTL_OFF + 1024); LAS float* RS = (LAS float*)(lds + LDS_CTL_OFF + 5120); const float* COS = (const float*)(ws + WS_COS); const float* SIN = (const float*)(ws + WS_SIN);
    bf16_t* XB = (bf16_t*)(ws + WS_XB); bf16_t* PROJ = (bf16_t*)(ws + WS_PROJ); bf16_t* ATT = (bf16_t*)(ws + WS_ATT); bf16_t* SGU = (bf16_t*)(ws + WS_SGU);
    bf16_t* MRG = (bf16_t*)(ws + WS_MRG); bf16_t* TMP = (bf16_t*)(ws + WS_TMP); bf16_t* ACT = (bf16_t*)(ws + WS_ACT);

    if (KON(0) && IN(0)) { const int vcu = (G % 8 == 0) ? (blk % 8) * (G / 8) + blk / 8 : blk; p0_prologue(args, vcu * NWAVES + wave, G * NWAVES, lane, 0x000Fu | 0x0010u | 0x0800u, true, 0x0810u, 0, 10); }
    SEAM(0);
#pragma unroll 1
    for (int l = 0; l < DEPTH; ++l) {
        const int pb = 1 + 6 * l;
        const bf16_t* WIN = (const bf16_t*)(ws + WS_WIN + l * SZ_WIN); const bf16_t* WA = (const bf16_t*)(ws + WS_WA + l * SZ_WA); const bf16_t* WB = (const bf16_t*)(ws + WS_WB + l * SZ_WB);
        const bf16_t* WO = (const bf16_t*)(ws + WS_WO + l * SZ_WO); const bf16_t* WGU = (const bf16_t*)(ws + WS_WGU + l * SZ_WGU); const bf16_t* WD = (const bf16_t*)(ws + WS_WD + l * SZ_WD);
        if (KON(1) && IN(pb + 0)) {
            pg8::Gemm g{XB, WIN, XB, WIN, pg8::MROWS, pg8::IN_W, 2048}; pg8::StaticOrder S; S.init(pg8::MROWS, pg8::IN_W, G, blk, 0);
            pg8::Unit u0; const int pm0 = S.next(0, u0) ? u0.pm : -1; if (pm0 >= 0) build_row_scale(RS, SSQ + (size_t)(2 * l) * 8 * pg8::MROWS, pm0, tid);
            pg8::EpiProj E{PROJ, SSQ + (size_t)(2 * l) * 8 * pg8::MROWS, RS, pm0};
            pg8::gemm_phase<pg8::EpiProj, pg8::StaticOrder, true, true>(lds, g, S, E);
            { int thr = S.nwg - ((S.nwg + G - 1) / G - 1) * G; if (thr >= G) thr = 0;
                if (blk >= thr) p0_prologue(args, (blk - thr) * NWAVES + wave, (G - thr) * NWAVES, lane, l == 0 ? 0x0030u : 0x1800u, false, l == 0 ? 0x0010u : 0x0800u, 10, 16); }
        }
        SEAM(pb + 0);
        if (KON(2) && IN(pb + 1)) {
            for (int it = blk; it < 256; it += G) p2_block(lds, PROJ, ATT, SGU, args.in[3] + l * 64, args.in[4] + l * 64, args.in[5] + l * 16, COS, SIN, args.in[6] + l * 1024, args.in[7] + l * 1024,
                                                           args.in[8] + (size_t)l * 8 * 16384, args.in[9] + l * 1024, it, tid);
        }
        SEAM(pb + 1);
        if (KON(3) && IN(pb + 2)) {
            pg8::Gemm g{ATT, WA, SGU, WB, pg8::MROWS, 2048, 1024}; pg8::StaticOrder S; S.init(pg8::MROWS, 2048, G, blk, 1);
            pg8::EpiMerge E{PROJ, MRG};
            pg8::gemm_phase<pg8::EpiMerge, pg8::StaticOrder, true, true>(lds, g, S, E);
        }
        SEAM(pb + 2);
        if (KON(4) && IN(pb + 3)) {
            pg8::Gemm g{MRG, WO, MRG, WO, pg8::MROWS, 2048, 2048}; pg8::StaticOrder S; S.init(pg8::MROWS, 2048, G, blk, 0);
            pg8::EpiRes E{args.out, XB, SSQ + (size_t)(2 * l + 1) * 8 * pg8::MROWS, 1, RED};
            pg8::gemm_phase<pg8::EpiRes, pg8::StaticOrder, true, true>(lds, g, S, E);
        }
        SEAM(pb + 3);
        if (KON(5) && IN(pb + 4)) {
            pg8::Gemm g{XB, WGU, XB, WGU, pg8::MROWS, 2 * pg8::D_FF, 2048}; pg8::StaticOrder S; S.init(pg8::MROWS, 2 * pg8::D_FF, G, blk, 0);
            pg8::Unit u0; const int pm0 = S.next(0, u0) ? u0.pm : -1; if (pm0 >= 0) build_row_scale(RS, SSQ + (size_t)(2 * l + 1) * 8 * pg8::MROWS, pm0, tid);
            pg8::EpiSwiglu E{ACT, SSQ + (size_t)(2 * l + 1) * 8 * pg8::MROWS, RS, pm0};
            pg8::gemm_phase<pg8::EpiSwiglu, pg8::StaticOrder, true, true>(lds, g, S, E);
            { int thr = S.nwg - ((S.nwg + G - 1) / G - 1) * G; if (thr >= G) thr = 0;
                if (blk >= thr) p0_prologue(args, (blk - thr) * NWAVES + wave, (G - thr) * NWAVES, lane, l == 0 ? 0x07C0u : 0x2000u, false); }
        }
        SEAM(pb + 4);
        if (KON(6) && IN(pb + 5)) {
            pg8::Gemm g{ACT, WD, ACT, WD, pg8::MROWS, 2048, pg8::D_FF}; pg8::StaticOrder S; S.init(pg8::MROWS, 2048, G, blk, 0);
            pg8::EpiRes E{args.out, XB, SSQ + (size_t)((2 * l + 2) & 3) * 8 * pg8::MROWS, l + 1 < DEPTH ? 1 : 0, RED};
            pg8::gemm_phase<pg8::EpiRes, pg8::StaticOrder, true, true>(lds, g, S, E);
        }
        SEAM(pb + 5);
    }
#undef IN
#undef SEAM
}

extern "C" void kernel_launch(void* const* d_in, const int* in_sizes, int n_in, void* d_out, int out_size, void* d_ws, size_t ws_size, hipStream_t stream) {
    static int grid = 0;
    if (grid == 0) {
        if (n_in != 17 || in_sizes[0] != pg8::MROWS * 2048 || out_size != pg8::MROWS * 2048 || ws_size < WS_END) { fprintf(stderr, "kernel_launch: unexpected shapes / workspace (n_in %d, ws %zu)\n", n_in, ws_size); grid = -1; return; }
        int dev = 0, cus = 0, per_cu = 0;
        if (hipGetDevice(&dev) != hipSuccess || hipDeviceGetAttribute(&cus, hipDeviceAttributeMultiprocessorCount, dev) != hipSuccess) { grid = -1; return; }
        if (hipFuncSetAttribute((const void*)mk_fwd, hipFuncAttributeMaxDynamicSharedMemorySize, LDS_BYTES) != hipSuccess) { fprintf(stderr, "kernel_launch: hipFuncSetAttribute failed\n"); grid = -1; return; }
        if (hipOccupancyMaxActiveBlocksPerMultiprocessor(&per_cu, (const void*)mk_fwd, NTHREADS, LDS_BYTES) != hipSuccess || per_cu < 1) { fprintf(stderr, "kernel_launch: occupancy query says %d\n", per_cu); per_cu = 1; }
        (void)hipGetLastError();
        grid = cus * per_cu;
    }
    if (grid < 0) return;
    if (hipMemsetAsync((unsigned char*)d_ws + WS_BAR, 0, BAR_BYTES, stream) != hipSuccess) { fprintf(stderr, "kernel_launch: memset of the barrier words failed\n"); return; }
    Args a{};
    for (int i = 0; i < 17; ++i) a.in[i] = (const float*)d_in[i];
    a.out = (float*)d_out; a.ws = (unsigned char*)d_ws;
#if MK_ONE_LAUNCH
    a.ph_lo = 0; a.ph_hi = NPHASES;
    void* kargs[] = {&a};
    const hipError_t e = hipLaunchCooperativeKernel((const void*)mk_fwd, dim3(grid), dim3(NTHREADS), kargs, LDS_BYTES, stream);
    if (e != hipSuccess) fprintf(stderr, "kernel_launch: cooperative launch failed: %s (grid %d)\n", hipGetErrorString(e), grid);
#else
    for (int p = 0; p < NPHASES; ++p) { a.ph_lo = p; a.ph_hi = p + 1; hipLaunchKernelGGL(mk_fwd, dim3(grid), dim3(NTHREADS), LDS_BYTES, stream, a); }
#endif
}
```
